# Optimizing an MI355X kernel written in HIP

```python
import jax
import jax.numpy as jnp
from jax import lax
import numpy as np

D_MODEL = 2048
BATCH = 2
SEQ = 16384
DEPTH = 1

HEAD_DIM = 64
MIX_WIDTH = D_MODEL
ATTN_WIDTH = MIX_WIDTH // 2
RWKV_WIDTH = MIX_WIDTH - ATTN_WIDTH
ATTN_HEADS = ATTN_WIDTH // HEAD_DIM
RWKV_HEADS = RWKV_WIDTH // HEAD_DIM
WINDOWS = (128, 512, 2048)
DILATIONS = (1, 4, 16)
ROT_DIM = HEAD_DIM // 4
ROPE_THETA = 500000.0
DECAY_LORA = 64
ICLR_LORA = 64
GATE_LORA = 160
RWKV_COLS = 3 * RWKV_WIDTH + DECAY_LORA + ICLR_LORA + GATE_LORA
IN_COLS = 3 * ATTN_WIDTH + RWKV_COLS
FFN_DIM = -(-(8 * D_MODEL) // (3 * 256)) * 256
RMS_EPS = 1e-6
GN_EPS = HEAD_DIM * 1e-5

kernel_name = 'hymba_dilated_rwkv7_adaln_layer'


def _rmsnorm(x, g):
    xf = x.astype(jnp.float32)
    y = xf * lax.rsqrt(jnp.mean(xf * xf, axis=-1, keepdims=True) + RMS_EPS)
    return (y * g.astype(jnp.float32)).astype(x.dtype)


def _partial_rope(t, positions):
    inv = ROPE_THETA ** (-jnp.arange(0, ROT_DIM, 2, dtype=jnp.float32) / ROT_DIM)
    ang = positions.astype(jnp.float32)[..., None] * inv
    cos = jnp.cos(ang)[:, :, None, :]
    sin = jnp.sin(ang)[:, :, None, :]
    half = ROT_DIM // 2
    r1 = t[..., :half].astype(jnp.float32)
    r2 = t[..., half:ROT_DIM].astype(jnp.float32)
    rot = jnp.concatenate([r1 * cos - r2 * sin, r2 * cos + r1 * sin], axis=-1).astype(t.dtype)
    return jnp.concatenate([rot, t[..., ROT_DIM:]], axis=-1)


def _dilated_branch(q, k, v, window, dilation):
    b, s, h, dh = q.shape
    blk = window // dilation
    unit = blk * dilation
    s_pad = -(-s // unit) * unit
    n_sub = s_pad // dilation
    nb = n_sub // blk

    def to_blocks(t):
        t = jnp.pad(t, ((0, 0), (0, s_pad - s), (0, 0), (0, 0)))
        t = t.reshape(b, n_sub, dilation, h, dh).transpose(0, 3, 2, 1, 4)
        return t.reshape(b, h, dilation, nb, blk, dh)

    def with_prev(t):
        prev = jnp.pad(t, ((0, 0), (0, 0), (0, 0), (1, 0), (0, 0), (0, 0)))[:, :, :, :-1]
        return jnp.concatenate([prev, t], axis=4)

    qb = to_blocks(q)
    kw = with_prev(to_blocks(k))
    vw = with_prev(to_blocks(v))
    scores = jnp.einsum('bhrnqd,bhrnkd->bhrnqk', qb, kw,
                        preferred_element_type=jnp.float32) * (dh ** -0.5)
    qi = jnp.arange(blk)[:, None]
    kj = jnp.arange(2 * blk)[None, :]
    steps = blk + qi - kj
    band = (steps >= 0) & (steps <= blk)
    valid = band[None] & ((jnp.arange(nb)[:, None, None] > 0) | (kj[None] >= blk))
    scores = jnp.where(valid, scores, -jnp.inf)
    m = jnp.max(scores, axis=-1, keepdims=True)
    p = jnp.exp(scores - m)
    l = jnp.sum(p, axis=-1, keepdims=True)
    o = jnp.einsum('bhrnqk,bhrnkd->bhrnqd', p, vw.astype(jnp.float32)) / l
    lse = (m + jnp.log(l))[..., 0]
    o = o.reshape(b, h, dilation, n_sub, dh).transpose(0, 3, 2, 1, 4).reshape(b, s_pad, h, dh)[:, :s]
    lse = lse.reshape(b, h, dilation, n_sub).transpose(0, 3, 2, 1).reshape(b, s_pad, h)[:, :s]
    return o, lse


def _dilated_mixture(q, k, v):
    outs, lses = zip(*[_dilated_branch(q, k, v, w, d) for w, d in zip(WINDOWS, DILATIONS)])
    wts = jax.nn.softmax(jnp.stack(lses, axis=0), axis=0)
    o = jnp.sum(wts[..., None] * jnp.stack(outs, axis=0), axis=0)
    return o.astype(q.dtype)


def _rwkv7(y, mu_shift, w0, w_decay_up, a0, w_iclr_up, w_gate_up, k_k, k_a, r_k, gn_g, gn_b):
    dt = y.dtype
    b, s, _ = y.shape
    yf = y.astype(jnp.float32)
    prev = jnp.pad(yf, ((0, 0), (1, 0), (0, 0)))[:, :-1]
    yf = yf + (prev - yf) * mu_shift
    c0 = RWKV_WIDTH
    r = yf[..., :c0]
    k = yf[..., c0:2 * c0]
    v = yf[..., 2 * c0:3 * c0]
    wl = yf[..., 3 * c0:3 * c0 + DECAY_LORA]
    al = yf[..., 3 * c0 + DECAY_LORA:3 * c0 + DECAY_LORA + ICLR_LORA]
    gl = yf[..., 3 * c0 + DECAY_LORA + ICLR_LORA:]
    w = -jax.nn.softplus(-(w0 + jnp.tanh(wl) @ w_decay_up)) - 0.5
    decay = jnp.exp(-jnp.exp(w))
    a = jax.nn.sigmoid(a0 + al @ w_iclr_up)
    g = jax.nn.sigmoid(gl) @ w_gate_up
    hd = lambda t: t.reshape(b, s, RWKV_HEADS, HEAD_DIM)
    kk = hd(k * k_k)
    kk = kk / jnp.maximum(jnp.sqrt(jnp.sum(kk * kk, axis=-1, keepdims=True)), 1e-12)
    k = k * (1.0 + (a - 1.0) * k_a)
    r_h, w_h, k_h, v_h, a_h = hd(r), hd(decay), hd(k), hd(v), hd(a)

    def step(state, inp):
        r_t, w_t, k_t, v_t, kk_t, a_t = inp
        sa = jnp.einsum('bhvk,bhk->bhv', state, -kk_t)
        state = (state * w_t[..., None, :]
                 + sa[..., :, None] * (kk_t * a_t)[..., None, :]
                 + v_t[..., :, None] * k_t[..., None, :])
        return state, jnp.einsum('bhvk,bhk->bhv', state, r_t)

    xs = tuple(jnp.moveaxis(t, 1, 0) for t in (r_h, w_h, k_h, v_h, kk, a_h))
    state0 = jnp.zeros((b, RWKV_HEADS, HEAD_DIM, HEAD_DIM), jnp.float32)
    _, outs = lax.scan(step, state0, xs)
    o = jnp.moveaxis(outs, 0, 1)
    mean = jnp.mean(o, axis=-1, keepdims=True)
    var = jnp.mean(jnp.square(o - mean), axis=-1, keepdims=True)
    o = ((o - mean) * lax.rsqrt(var + GN_EPS)).reshape(b, s, RWKV_WIDTH) * gn_g + gn_b
    bonus = jnp.sum(r_h * k_h * r_k, axis=-1, keepdims=True) * v_h
    o = (o + bonus.reshape(b, s, RWKV_WIDTH)) * g
    return o.astype(dt)


def _swiglu(h, w_gate, w_up, w_down):
    return (jax.nn.silu(h @ w_gate) * (h @ w_up)) @ w_down


def setup_inputs(seed: int = 0) -> dict:
    key = jax.random.key(seed)
    ks = jax.random.split(key, 26)
    f32 = jnp.float32
    L = DEPTH

    def nrm(k, shape, scale):
        return jax.random.normal(k, shape, f32) * scale

    return {
        'x': nrm(ks[0], (BATCH, SEQ, D_MODEL), 1.0),
        'c': nrm(ks[1], (BATCH, D_MODEL), 1.0),
        'positions': jnp.broadcast_to(jnp.arange(SEQ, dtype=jnp.int32), (BATCH, SEQ)),
        'w_ada': nrm(ks[2], (L, D_MODEL, 6 * D_MODEL), 0.5 * D_MODEL ** -0.5),
        'b_ada': nrm(ks[3], (L, 6 * D_MODEL), 0.01),
        'norm1_g': 1.0 + nrm(ks[4], (L, D_MODEL), 0.05),
        'norm2_g': 1.0 + nrm(ks[5], (L, D_MODEL), 0.05),
        'normf_g': 1.0 + nrm(ks[6], (D_MODEL,), 0.05),
        'w_in': nrm(ks[7], (L, D_MODEL, IN_COLS), D_MODEL ** -0.5),
        'w_out': nrm(ks[8], (L, MIX_WIDTH, D_MODEL), MIX_WIDTH ** -0.5),
        'mu_shift': jax.random.uniform(ks[9], (L, RWKV_COLS), f32, 0.0, 1.0),
        'w0': jax.random.uniform(ks[10], (L, RWKV_WIDTH), f32, -6.0, 1.0),
        'w_decay_up': nrm(ks[11], (L, DECAY_LORA, RWKV_WIDTH), 0.5 * DECAY_LORA ** -0.5),
        'a0': nrm(ks[12], (L, RWKV_WIDTH), 0.1),
        'w_iclr_up': nrm(ks[13], (L, ICLR_LORA, RWKV_WIDTH), 0.5 * ICLR_LORA ** -0.5),
        'w_gate_up': nrm(ks[14], (L, GATE_LORA, RWKV_WIDTH), GATE_LORA ** -0.5),
        'k_k': 0.85 + nrm(ks[15], (L, RWKV_WIDTH), 0.05),
        'k_a': 1.0 + nrm(ks[16], (L, RWKV_WIDTH), 0.05),
        'r_k': nrm(ks[17], (L, RWKV_HEADS, HEAD_DIM), 0.1),
        'gn_g': 1.0 + nrm(ks[18], (L, RWKV_WIDTH), 0.05),
        'gn_b': nrm(ks[19], (L, RWKV_WIDTH), 0.01),
        'w_ffn_gate': nrm(ks[20], (L, D_MODEL, FFN_DIM), D_MODEL ** -0.5),
        'w_ffn_up': nrm(ks[21], (L, D_MODEL, FFN_DIM), D_MODEL ** -0.5),
        'w_ffn_down': nrm(ks[22], (L, FFN_DIM, D_MODEL), FFN_DIM ** -0.5),
    }


def reference(x, c, positions, w_ada, b_ada, norm1_g, norm2_g, normf_g, w_in, w_out,
              mu_shift, w0, w_decay_up, a0, w_iclr_up, w_gate_up, k_k, k_a, r_k,
              gn_g, gn_b, w_ffn_gate, w_ffn_up, w_ffn_down):
    b, s, _ = x.shape
    for i in range(DEPTH):
        ada = (jax.nn.silu(c) @ w_ada[i] + b_ada[i])[:, None, :]
        sh1, sc1, gt1, sh2, sc2, gt2 = jnp.split(ada, 6, axis=-1)
        h = _rmsnorm(x, norm1_g[i]) * (1.0 + sc1) + sh1
        proj = h @ w_in[i]
        q = proj[..., :ATTN_WIDTH].reshape(b, s, ATTN_HEADS, HEAD_DIM)
        k = proj[..., ATTN_WIDTH:2 * ATTN_WIDTH].reshape(b, s, ATTN_HEADS, HEAD_DIM)
        v = proj[..., 2 * ATTN_WIDTH:3 * ATTN_WIDTH].reshape(b, s, ATTN_HEADS, HEAD_DIM)
        q = _partial_rope(q, positions)
        k = _partial_rope(k, positions)
        attn = _dilated_mixture(q, k, v).reshape(b, s, ATTN_WIDTH)
        rwkv = _rwkv7(proj[..., 3 * ATTN_WIDTH:], mu_shift[i], w0[i], w_decay_up[i], a0[i],
                      w_iclr_up[i], w_gate_up[i], k_k[i], k_a[i], r_k[i], gn_g[i], gn_b[i])
        mix = jnp.concatenate([attn, rwkv], axis=-1) @ w_out[i]
        x = x + gt1 * mix
        h2 = _rmsnorm(x, norm2_g[i]) * (1.0 + sc2) + sh2
        x = x + gt2 * _swiglu(h2, w_ffn_gate[i], w_ffn_up[i], w_ffn_down[i])
    return _rmsnorm(x, normf_g)
```

```cpp
#include <hip/hip_runtime.h>
#include <hip/hip_cooperative_groups.h>
#include <cstdio>
#include <cstdint>
namespace cg = cooperative_groups;

#define LAS __attribute__((address_space(3)))
typedef unsigned short bf16_t;
typedef short bf16x8 __attribute__((ext_vector_type(8)));
typedef short s16x4 __attribute__((ext_vector_type(4)));
typedef float f32x4 __attribute__((ext_vector_type(4)));
typedef float f32x2 __attribute__((ext_vector_type(2)));
typedef unsigned u32x4 __attribute__((ext_vector_type(4)));
typedef unsigned u32x2 __attribute__((ext_vector_type(2)));

constexpr int BATCH = 2, SEQ = 16384, DM = 2048, T = BATCH * SEQ;
constexpr int NPROJ = 6432, LDP = 6656;
constexpr int FF = 5632;
constexpr int ADA_N = 6 * DM;
constexpr int CL = 256, NCH = SEQ / CL;
constexpr int NCHAIN = BATCH * 16;
constexpr int PC_Q = 0, PC_K = 1024, PC_V = 2048, PC_R = 3072, PC_RK = 4096, PC_RV = 5120, PC_WL = 6144, PC_AL = 6208, PC_GL = 6272;

constexpr size_t MiB = 1u << 20;
constexpr size_t WS_CTL = 0;
constexpr size_t WS_ADAP = 1 * MiB;
constexpr size_t WS_ADA = 14 * MiB;
constexpr size_t WS_ROPE = 15 * MiB;
constexpr size_t WS_KKN = 17 * MiB;
constexpr size_t WS_LSE = 19 * MiB;
constexpr size_t WS_WLORA = 25 * MiB;
constexpr size_t WS_WIN = 27 * MiB;
constexpr size_t WS_WOUT = 53 * MiB;
constexpr size_t WS_WGU = 61 * MiB;
constexpr size_t WS_WDOWN = 105 * MiB;
constexpr size_t WS_LACT = 127 * MiB;
constexpr size_t WS_CS = 175 * MiB;
constexpr size_t WS_SINIT = 239 * MiB;
constexpr size_t WS_PROJ = 271 * MiB;
constexpr size_t WS_HBUF = 687 * MiB;
constexpr size_t WS_MIX = 815 * MiB;
constexpr size_t WS_OP2 = 943 * MiB;
constexpr size_t WS_END = 1007 * MiB;

constexpr int LDS_BYTES = 147456;

__device__ __forceinline__ float bf2f(bf16_t v) { return __uint_as_float((unsigned)v << 16); }
__device__ __forceinline__ unsigned f2bf(float f) { unsigned u = __float_as_uint(f); return (u + 0x7fffu + ((u >> 16) & 1u)) >> 16; }
__device__ __forceinline__ unsigned pk2(float lo, float hi) { return f2bf(lo) | (f2bf(hi) << 16); }
__device__ __forceinline__ unsigned pk2hw(float lo, float hi) { unsigned r; asm volatile("v_cvt_pk_bf16_f32 %0, %1, %2" : "=v"(r) : "v"(lo), "v"(hi)); return r; }
__device__ __forceinline__ float wave_sum(float v) {
#pragma unroll
    for (int o = 1; o < 64; o <<= 1) v += __shfl_xor(v, o);
    return v;
}
__device__ __forceinline__ float sigmoidf_(float x) { return 1.0f / (1.0f + __expf(-x)); }
#define LDS_WAIT() asm volatile("s_waitcnt lgkmcnt(0)" ::: "memory")
__device__ __forceinline__ int opaque_tid(int wave_s) { int t = (wave_s << 6) | (int)__builtin_amdgcn_mbcnt_hi(~0u, __builtin_amdgcn_mbcnt_lo(~0u, 0u)); asm volatile("" : "+v"(t)); return t; }

template <int CTRL> __device__ __forceinline__ float dpp_mov(float v) { return __int_as_float(__builtin_amdgcn_update_dpp(0, __float_as_int(v), CTRL, 0xF, 0xF, true)); }
__device__ __forceinline__ float wave_sum_dpp(float v) {
    v += dpp_mov<0xB1>(v); v += dpp_mov<0x4E>(v); v += dpp_mov<0x141>(v); v += dpp_mov<0x140>(v);
    const int vi = __float_as_int(v);
    return (__int_as_float(__builtin_amdgcn_readlane(vi, 0)) + __int_as_float(__builtin_amdgcn_readlane(vi, 16))) + (__int_as_float(__builtin_amdgcn_readlane(vi, 32)) + __int_as_float(__builtin_amdgcn_readlane(vi, 48)));
}

#define XB_TMO      128
#define XB_XCNT(j)  (256  + 64 * (j))
#define XB_XSUB(j)  (1280 + 64 * (j))
#define XB_XGEN(j)  (2304 + 64 * (j))
#define XB_TOP      3328
#define XB_TOPGEN   3392
#define XCD_BAR_WORDS 3456
#define XB_SPIN_CAP (1u << 22)
__device__ __forceinline__ unsigned xb_ld(unsigned* p)              { return __hip_atomic_load(p, __ATOMIC_RELAXED, __HIP_MEMORY_SCOPE_AGENT); }
__device__ __forceinline__ unsigned xb_add(unsigned* p, unsigned v) { return __hip_atomic_fetch_add(p, v, __ATOMIC_RELAXED, __HIP_MEMORY_SCOPE_AGENT); }
__device__ __forceinline__ unsigned xb_xcc_id() { return (unsigned)__builtin_amdgcn_s_getreg((3 << 11) | 20) & 0xFu; }
#define XB_SPIN(cond, bar) do { unsigned _sp = 0; while (cond) { __builtin_amdgcn_s_sleep(1); \
    if ((++_sp & 255u) == 0u) { if (xb_ld(&(bar)[XB_TMO])) break; if (_sp > XB_SPIN_CAP) { atomicAdd(&(bar)[XB_TMO], 1u); break; } } } } while (0)
struct XcdBarrier { unsigned* bar; unsigned x; volatile LAS unsigned* st; };
__device__ __forceinline__ XcdBarrier xcd_barrier_post(unsigned* bar, volatile LAS unsigned* st, bool leader) {
    XcdBarrier b; b.bar = bar; b.x = xb_xcc_id(); b.st = st;
    if (leader) (void)xb_add(&bar[XB_XCNT(b.x)], 1u);
    return b;
}
__device__ __forceinline__ void xcd_barrier_complete(unsigned* bar, unsigned x, unsigned& nloc, unsigned& nx) {
    const unsigned G = gridDim.x * gridDim.y * gridDim.z;
    unsigned sum, cnt, mine, sp = 0u;
    for (;;) {
        sum = 0u; cnt = 0u; mine = 0u;
#pragma unroll
        for (unsigned j = 0; j < 16; ++j) { const unsigned c = xb_ld(&bar[XB_XCNT(j)]); sum += c; cnt += (c > 0u) ? 1u : 0u; mine = (j == x) ? c : mine; }
        if (sum == G) break;
        __builtin_amdgcn_s_sleep(1);
        if ((++sp & 255u) == 0u) { if (xb_ld(&bar[XB_TMO])) break; if (sp > XB_SPIN_CAP) { atomicAdd(&bar[XB_TMO], 1u); break; } }
    }
    nloc = mine > 0u ? mine : 1u; nx = cnt > 0u ? cnt : 1u;
}
__device__ __forceinline__ void xcd_barrier(const XcdBarrier& b, int wave_s) {
    asm volatile("s_waitcnt vmcnt(0)" ::: "memory");
    __syncthreads();
    if (opaque_tid(wave_s) == 0) {
        unsigned* bar = b.bar;
        __builtin_amdgcn_s_waitcnt(0);
        unsigned nloc = b.st[0], nx = b.st[1];
        if (nloc == 0u) { xcd_barrier_complete(bar, b.x, nloc, nx); b.st[0] = nloc; b.st[1] = nx; }
        const unsigned old = xb_add(&bar[XB_XSUB(b.x)], 1u);
        const unsigned gen = old / nloc;
        if (old + 1u == (gen + 1u) * nloc) {
            __builtin_amdgcn_fence(__ATOMIC_RELEASE, "agent");
            asm volatile("s_waitcnt vmcnt(0)" ::: "memory");
            const unsigned og = xb_add(&bar[XB_TOP], 1u);
            const unsigned tg = og / nx;
            if (og + 1u == (tg + 1u) * nx) xb_add(&bar[XB_TOPGEN], 1u);
            else XB_SPIN(xb_ld(&bar[XB_TOPGEN]) == tg, bar);
            __builtin_amdgcn_fence(__ATOMIC_ACQUIRE, "agent");
            xb_add(&bar[XB_XGEN(b.x)], 1u);
            asm volatile("s_waitcnt vmcnt(0)" ::: "memory");
        } else {
            XB_SPIN(xb_ld(&bar[XB_XGEN(b.x)]) == gen, bar);
            __builtin_amdgcn_fence(__ATOMIC_ACQUIRE, "agent");
            asm volatile("s_waitcnt vmcnt(0)" ::: "memory");
        }
    }
    __syncthreads();
}

namespace pg8 {
#define PG8_LAS __attribute__((address_space(3)))
constexpr int BM = 256, BK = 64, HALF = 128, HTB = HALF * BK * 2, STAGE_BYTES = 8 * HTB, NXCD = 8, WGM = 8;

__host__ __device__ __forceinline__ int lds_byte(int r, int c) { const int st = (r >> 4) * 2 + (c >> 5), rr = r & 15, cc = c & 31, ob = rr * 64 + cc * 2; return st * 1024 + (ob ^ (((ob >> 9) & 1) << 5)); }
__host__ __device__ __forceinline__ void stage_rc(int b, int& R, int& C) { const int st = b / 1024, sb = b % 1024, swz = sb ^ (((sb >> 9) & 1) << 5); R = (st >> 1) * 16 + swz / 64; C = (st & 1) * 32 + (swz % 64) / 2; }
__host__ __device__ __forceinline__ int perm32(int rho) { const int n = rho >> 4, i = rho & 15; return 8 * (i >> 2) + 4 * n + (i & 3); }

struct Unit { int pm, pn; };
struct Gemm { const bf16_t* A; const bf16_t* Bt; int M, N, K, lda, ldb, agrp, kshort; };

struct StaticOrder {
    int nM, nN, nwg, G, c;
    __host__ __device__ void init(int M, int N, int G_, int c_) { nM = M / BM; nN = N / BM; nwg = nM * nN; G = G_; c = c_; }
    __host__ __device__ bool next(int i, Unit& u) const {
        const long L = (long)i * G + c; if (L >= nwg) return false;
        int wgid = (int)L; { const int q = nwg / NXCD, r = nwg % NXCD, xcd = wgid % NXCD, off = wgid / NXCD; wgid = (xcd < r ? xcd * (q + 1) : r * (q + 1) + (xcd - r) * q) + off; }
        const int nig = WGM * nN, gid = wgid / nig, fm = gid * WGM, gsz = (nM - fm) < WGM ? (nM - fm) : WGM;
        u.pm = fm + ((wgid % nig) % gsz); u.pn = (wgid % nig) / gsz; return true;
    }
};

__device__ __forceinline__ unsigned cvt_pk_bf16(float lo, float hi) { unsigned r; asm volatile("v_cvt_pk_bf16_f32 %0, %1, %2" : "=v"(r) : "v"(lo), "v"(hi)); return r; }


struct EpiProj {
    static constexpr bool PERM = true;
    bf16_t* O; int ldc; const float* rope;
    __device__ __forceinline__ void operator()(f32x4 (&acc)[2][2][4][2], const Unit& u, int wr, int wc, int fr, int fq) const {
        const int row0 = u.pm * BM + wr * 64 + fr;
        const float sc = (u.pn < 4) ? 0.125f : 1.0f;
        if (u.pn < 8 && (wc & 1) == 0) {
            const float sg = (fq == 0) ? -1.0f : 1.0f;
            const bool act = fq < 2;
#pragma unroll
            for (int ai = 0; ai < 2; ++ai)
#pragma unroll
                for (int m = 0; m < 4; ++m) {
                    const int row = row0 + ai * HALF + m * 16;
                    const f32x4* rp = (const f32x4*)(rope + (size_t)row * 16);
                    const f32x4 cz[2] = {rp[0], rp[1]}, sz[2] = {rp[2], rp[3]};
#pragma unroll
                    for (int bj = 0; bj < 2; ++bj)
#pragma unroll
                        for (int n = 0; n < 2; ++n) {
                            f32x4 x = acc[ai][bj][m][n], p;
#pragma unroll
                            for (int j = 0; j < 4; ++j) p[j] = __shfl_xor(x[j], 16);
                            const f32x4 y = x * cz[n] + (p * sz[n]) * sg;
                            acc[ai][bj][m][n] = act ? y : x;
                        }
                }
        }
        const int col0 = u.pn * BM + wc * 32 + 8 * fq;
#pragma unroll
        for (int ai = 0; ai < 2; ++ai)
#pragma unroll
            for (int m = 0; m < 4; ++m) { bf16_t* rowp = O + (size_t)(row0 + ai * HALF + m * 16) * ldc + col0;
#pragma unroll
                for (int bj = 0; bj < 2; ++bj) { const f32x4 v0 = acc[ai][bj][m][0] * sc, v1 = acc[ai][bj][m][1] * sc;
                    u32x4 w; w.x = cvt_pk_bf16(v0[0], v0[1]); w.y = cvt_pk_bf16(v0[2], v0[3]); w.z = cvt_pk_bf16(v1[0], v1[1]); w.w = cvt_pk_bf16(v1[2], v1[3]);
                    *(u32x4*)(rowp + bj * HALF) = w; } }
    }
};

typedef _Float16 f16x2 __attribute__((ext_vector_type(2)));
__device__ __forceinline__ unsigned pk_f16(float lo, float hi) { f16x2 h; h.x = (_Float16)lo; h.y = (_Float16)hi; return __builtin_bit_cast(unsigned, h); }
struct EpiLora {
    static constexpr bool PERM = true;
    _Float16* O; const float* bias;
    __device__ __forceinline__ void operator()(f32x4 (&acc)[2][2][4][2], const Unit& u, int wr, int wc, int fr, int fq) const {
        const int row0 = u.pm * BM + wr * 64 + fr, col0 = u.pn * BM + wc * 32 + 8 * fq;
        const int grp = u.pn >> 2; const float alpha = (grp == 0) ? 0.60653066f : (grp == 1) ? 1.0f : 0.0f, beta = (grp == 2) ? 1.0f : 0.0f;
        f32x4 bv[2][2];
#pragma unroll
        for (int bj = 0; bj < 2; ++bj)
#pragma unroll
            for (int n = 0; n < 2; ++n) bv[bj][n] = *(const f32x4*)(bias + col0 + bj * HALF + 4 * n);
#pragma unroll
        for (int ai = 0; ai < 2; ++ai)
#pragma unroll
            for (int m = 0; m < 4; ++m) { _Float16* rowp = O + (size_t)(row0 + ai * HALF + m * 16) * 3072 + col0;
#pragma unroll
                for (int bj = 0; bj < 2; ++bj) { f32x4 v0 = acc[ai][bj][m][0] + bv[bj][0], v1 = acc[ai][bj][m][1] + bv[bj][1];
#pragma unroll
                    for (int j = 0; j < 4; ++j) { v0[j] = alpha * __builtin_amdgcn_rcpf(1.0f + __expf(-v0[j])) + beta * v0[j]; v1[j] = alpha * __builtin_amdgcn_rcpf(1.0f + __expf(-v1[j])) + beta * v1[j]; }
                    u32x4 w; w.x = pk_f16(v0[0], v0[1]); w.y = pk_f16(v0[2], v0[3]); w.z = pk_f16(v1[0], v1[1]); w.w = pk_f16(v1[2], v1[3]);
                    *(u32x4*)(rowp + bj * HALF) = w; } }
    }
};

struct EpiResid {
    static constexpr bool PERM = false;
    const float* base; float* out; const float* gate;
    __device__ __forceinline__ void operator()(f32x4 (&acc)[2][2][4][2], const Unit& u, int wr, int wc, int fr, int fq) const {
        const int row0 = u.pm * BM + wr * 64 + fr, col0 = u.pn * BM + wc * 32 + 4 * fq;
        const float* gp = gate + ((u.pm * BM) >= SEQ ? ADA_N : 0) + col0;
        f32x4 gv[2][2];
#pragma unroll
        for (int bj = 0; bj < 2; ++bj)
#pragma unroll
            for (int n = 0; n < 2; ++n) gv[bj][n] = *(const f32x4*)(gp + bj * HALF + n * 16);
#pragma unroll
        for (int ai = 0; ai < 2; ++ai)
#pragma unroll
            for (int m = 0; m < 4; ++m) { const size_t off = (size_t)(row0 + ai * HALF + m * 16) * DM + col0;
#pragma unroll
                for (int bj = 0; bj < 2; ++bj)
#pragma unroll
                    for (int n = 0; n < 2; ++n) { const f32x4 bs = *(const f32x4*)(base + off + bj * HALF + n * 16);
                        *(f32x4*)(out + off + bj * HALF + n * 16) = bs + gv[bj][n] * acc[ai][bj][m][n]; } }
    }
};

struct PanelOrder {
    int c;
    __device__ __forceinline__ bool next(int i, Unit& u) const { if (i >= 4) return false; const int x = c & 7, l = c >> 3; u.pm = x * 16 + i * 4 + (l >> 3); u.pn = l & 7; return true; }
};
template <bool MID> struct EpiResidNorm {
    static constexpr bool PERM = false;
    const float* base; float* out; const float* gate; const float* gf; unsigned* xbuf; unsigned* cnt; PG8_LAS float* ls;
    bf16_t* hb; const float* adab;
    __device__ __forceinline__ void operator()(f32x4 (&acc)[2][2][4][2], const Unit& u, int wr, int wc, int fr, int fq) const {
        const int rl0 = wr * 64 + fr, col0 = u.pn * BM + wc * 32 + 4 * fq, tid = (wr * 4 + wc) * 64 + fq * 16 + fr;
        PG8_LAS float* P = ls; PG8_LAS float* S = ls + 1024;
        const float* gp = gate + ((u.pm * BM) >= SEQ ? ADA_N : 0) + col0;
        f32x4 gv[2][2];
#pragma unroll
        for (int bj = 0; bj < 2; ++bj)
#pragma unroll
            for (int n = 0; n < 2; ++n) gv[bj][n] = *(const f32x4*)(gp + bj * HALF + n * 16);
#pragma unroll
        for (int ai = 0; ai < 2; ++ai)
#pragma unroll
            for (int m = 0; m < 4; ++m) { const int rl = rl0 + ai * HALF + m * 16; const size_t off = (size_t)(u.pm * BM + rl) * DM + col0; float ss = 0.f;
#pragma unroll
                for (int bj = 0; bj < 2; ++bj)
#pragma unroll
                    for (int n = 0; n < 2; ++n) { const f32x4 bs = *(const f32x4*)(base + off + bj * HALF + n * 16); const f32x4 o = bs + gv[bj][n] * acc[ai][bj][m][n];
                        acc[ai][bj][m][n] = o; ss += (o.x * o.x + o.y * o.y) + (o.z * o.z + o.w * o.w); }
                ss += __shfl_xor(ss, 16); ss += __shfl_xor(ss, 32);
                if (fq == 0) P[rl * 4 + wc] = ss; }
        asm volatile("s_waitcnt lgkmcnt(0)" ::: "memory"); __builtin_amdgcn_s_barrier(); asm volatile("" ::: "memory");
        if (tid < 256) { const f32x4 p4 = *(const PG8_LAS f32x4*)(P + tid * 4);
            __hip_atomic_store(xbuf + (size_t)(u.pm * 8 + u.pn) * 256 + tid, __float_as_uint((p4.x + p4.y) + (p4.z + p4.w)), __ATOMIC_RELAXED, __HIP_MEMORY_SCOPE_AGENT); }
        asm volatile("s_waitcnt vmcnt(0)" ::: "memory"); __builtin_amdgcn_s_barrier(); asm volatile("" ::: "memory");
        if (tid == 0) {
            __builtin_amdgcn_fence(__ATOMIC_RELEASE, "agent"); asm volatile("s_waitcnt vmcnt(0)" ::: "memory");
            __hip_atomic_fetch_add(cnt + 64 * u.pm, 1u, __ATOMIC_RELAXED, __HIP_MEMORY_SCOPE_AGENT);
            unsigned sp = 0;
            while (__hip_atomic_load(cnt + 64 * u.pm, __ATOMIC_RELAXED, __HIP_MEMORY_SCOPE_AGENT) < 8u) { __builtin_amdgcn_s_sleep(2); if (++sp > (1u << 22)) break; }
            __builtin_amdgcn_fence(__ATOMIC_ACQUIRE, "agent"); asm volatile("s_waitcnt vmcnt(0)" ::: "memory");
        }
        asm volatile("s_waitcnt lgkmcnt(0)" ::: "memory"); __builtin_amdgcn_s_barrier(); asm volatile("" ::: "memory");
        if (tid < 256) { float sq = 0.f;
#pragma unroll
            for (int t = 0; t < 8; ++t) sq += __uint_as_float(__hip_atomic_load(xbuf + (size_t)(u.pm * 8 + t) * 256 + tid, __ATOMIC_RELAXED, __HIP_MEMORY_SCOPE_AGENT));
            S[tid] = __builtin_amdgcn_rsqf(sq * (1.0f / DM) + 1e-6f); }
        asm volatile("s_waitcnt lgkmcnt(0)" ::: "memory"); __builtin_amdgcn_s_barrier(); asm volatile("" ::: "memory");
        f32x4 fv[2][2];
        const float* ab = adab + ((u.pm * BM) >= SEQ ? ADA_N : 0) + col0;
#pragma unroll
        for (int bj = 0; bj < 2; ++bj)
#pragma unroll
            for (int n = 0; n < 2; ++n) { fv[bj][n] = *(const f32x4*)(gf + col0 + bj * HALF + n * 16);
                if (MID) fv[bj][n] = fv[bj][n] * (*(const f32x4*)(ab + 4 * DM + bj * HALF + n * 16) + 1.0f); }
#pragma unroll
        for (int ai = 0; ai < 2; ++ai)
#pragma unroll
            for (int m = 0; m < 4; ++m) { const int rl = rl0 + ai * HALF + m * 16; const size_t off = (size_t)(u.pm * BM + rl) * DM + col0; const float rs = S[rl];
#pragma unroll
                for (int bj = 0; bj < 2; ++bj)
#pragma unroll
                    for (int n = 0; n < 2; ++n) {
                        if (MID) { const f32x4 o = acc[ai][bj][m][n]; *(f32x4*)(out + off + bj * HALF + n * 16) = o;
                            const f32x4 y = (o * rs) * fv[bj][n] + *(const f32x4*)(ab + 3 * DM + bj * HALF + n * 16); u32x2 w; w.x = cvt_pk_bf16(y.x, y.y); w.y = cvt_pk_bf16(y.z, y.w); *(u32x2*)(hb + off + bj * HALF + n * 16) = w; }
                        else *(f32x4*)(out + off + bj * HALF + n * 16) = (acc[ai][bj][m][n] * rs) * fv[bj][n]; } }
    }
};

struct EpiSwiglu {
    static constexpr bool PERM = true;
    bf16_t* O;
    __device__ __forceinline__ void operator()(f32x4 (&acc)[2][2][4][2], const Unit& u, int wr, int wc, int fr, int fq) const {
        const int row0 = u.pm * BM + wr * 64 + fr, col0 = u.pn * HALF + wc * 32 + 8 * fq;
#pragma unroll
        for (int ai = 0; ai < 2; ++ai)
#pragma unroll
            for (int m = 0; m < 4; ++m) {
                f32x4 h[2];
#pragma unroll
                for (int n = 0; n < 2; ++n) { const f32x4 gte = acc[ai][0][m][n], up = acc[ai][1][m][n];
#pragma unroll
                    for (int j = 0; j < 4; ++j) h[n][j] = gte[j] * __builtin_amdgcn_rcpf(1.0f + __expf(-gte[j])) * up[j]; }
                u32x4 w; w.x = cvt_pk_bf16(h[0][0], h[0][1]); w.y = cvt_pk_bf16(h[0][2], h[0][3]); w.z = cvt_pk_bf16(h[1][0], h[1][1]); w.w = cvt_pk_bf16(h[1][2], h[1][3]);
                *(u32x4*)(O + (size_t)(row0 + ai * HALF + m * 16) * FF + col0) = w;
            }
    }
};

template <class Epi, class Sched>
__device__ __forceinline__ void gemm_phase(PG8_LAS unsigned char* lds, const Gemm g, const Sched& S, const Epi& E, int wave_s) {
    const int tid = opaque_tid(wave_s), wid = __builtin_amdgcn_readfirstlane(tid >> 6), lane = tid & 63, wr = wid >> 2, wc = wid & 3, fr = lane & 15, fq = lane >> 4;
    const int K = g.K;
#define PG8_NT(un) ((g.kshort > 0 && ((un).pn >> 2) < 2) ? g.kshort / BK : K / BK)
    unsigned voffA[2], voffB[2];
#pragma unroll
    for (int i = 0; i < 2; ++i) { int R, C; stage_rc(tid * 16 + i * 8192, R, C); const int Rb = Epi::PERM ? ((R & ~31) + perm32(R & 31)) : R;
        voffA[i] = (unsigned)(R * g.lda + C) * 2u; voffB[i] = (unsigned)(Rb * g.ldb + C) * 2u; }
    const size_t kstep = (size_t)(BK * 2);
    const size_t hstepA = (size_t)HALF * g.lda * 2, hstepB = (size_t)HALF * g.ldb * 2;
    const size_t tstepA = 2 * hstepA, tstepB = 2 * hstepB;
    const unsigned ldsw = (unsigned)wid * 1024u;
    const int aoff = lds_byte(wr * 64 + fr, fq * 8), boff = lds_byte(wc * 32 + fr, fq * 8);
#define PG8_SA(b, h) (((b) * 2 + (h)) * HTB)
#define PG8_SB(b, h) ((4 + (b) * 2 + (h)) * HTB)
#define PG8_STAGE(bufoff, gbase, voff) do { _Pragma("unroll") for (int _i = 0; _i < 2; ++_i) \
        __builtin_amdgcn_global_load_lds((const unsigned*)((const char*)(gbase) + (voff)[_i]), (PG8_LAS unsigned*)(lds + (bufoff) + ldsw + _i * 8192), 16, 0, 0); } while (0)
#define PG8_LDA(dst, b, h) do { _Pragma("unroll") for (int m = 0; m < 4; ++m) _Pragma("unroll") for (int k = 0; k < 2; ++k) dst[m][k] = *(const PG8_LAS bf16x8*)(lds + PG8_SA(b, h) + aoff + m * 2048 + k * 1024); } while (0)
#define PG8_LDB(dst, b, h) do { _Pragma("unroll") for (int n = 0; n < 2; ++n) _Pragma("unroll") for (int k = 0; k < 2; ++k) dst[n][k] = *(const PG8_LAS bf16x8*)(lds + PG8_SB(b, h) + boff + n * 2048 + k * 1024); } while (0)
#define PG8_MMA(ai, bj, At, Bt) do { __builtin_amdgcn_s_setprio(1); _Pragma("unroll") for (int m = 0; m < 4; ++m) _Pragma("unroll") for (int n = 0; n < 2; ++n) _Pragma("unroll") for (int k = 0; k < 2; ++k) \
        acc[ai][bj][m][n] = __builtin_amdgcn_mfma_f32_16x16x32_bf16(Bt[n][k], At[m][k], acc[ai][bj][m][n], 0, 0, 0); __builtin_amdgcn_s_setprio(0); } while (0)
#define PG8_WAIT_V(n) asm volatile("s_waitcnt vmcnt(" #n ")" ::: "memory")
#define PG8_WAIT_L(n) asm volatile("s_waitcnt lgkmcnt(" #n ")" ::: "memory")
#define PG8_BAR __builtin_amdgcn_s_barrier()
#define PG8_SCHED __builtin_amdgcn_sched_barrier(0)
    Unit cur, nxt; int ui = 0;
    if (!S.next(0, cur)) return;
    int nt = PG8_NT(cur);
    f32x4 acc[2][2][4][2];
#pragma unroll
    for (int a = 0; a < 2; ++a)
#pragma unroll
        for (int b = 0; b < 2; ++b)
#pragma unroll
            for (int m = 0; m < 4; ++m)
#pragma unroll
                for (int n = 0; n < 2; ++n) acc[a][b][m][n] = (f32x4){0.f, 0.f, 0.f, 0.f};
    bf16x8 At[4][2], B0[2][2], B1[2][2];
    const char* cA = (const char*)g.A + (size_t)cur.pm * tstepA + (size_t)((cur.pn >> 2) * g.agrp) * 2; const char* cB = (const char*)g.Bt + (size_t)cur.pn * tstepB;
    PG8_STAGE(PG8_SB(0, 0), cB, voffB); PG8_STAGE(PG8_SB(0, 1), cB + hstepB, voffB); PG8_STAGE(PG8_SA(0, 0), cA, voffA); PG8_STAGE(PG8_SA(0, 1), cA + hstepA, voffA);
    if (wr == 1) PG8_BAR;
    PG8_WAIT_V(2); PG8_BAR;
    PG8_STAGE(PG8_SB(1, 0), cB + kstep, voffB); PG8_STAGE(PG8_SA(1, 0), cA + kstep, voffA); PG8_STAGE(PG8_SB(1, 1), cB + hstepB + kstep, voffB);
    PG8_WAIT_V(6); PG8_BAR;
    for (;;) {
        const bool has_next = S.next(ui + 1, nxt);
        const char* nA = has_next ? (const char*)g.A + (size_t)nxt.pm * tstepA + (size_t)((nxt.pn >> 2) * g.agrp) * 2 : cA; const char* nB = has_next ? (const char*)g.Bt + (size_t)nxt.pn * tstepB : cB;
        for (int t = 0; t < nt; t += 2) {
            const bool last = (t == nt - 2);
            const char* a1 = cA + (size_t)(t + 1) * kstep;
            const char* a2 = last ? nA : cA + (size_t)(t + 2) * kstep; const char* b2 = last ? nB : cB + (size_t)(t + 2) * kstep;
            const char* a3 = a2 + kstep; const char* b3 = b2 + kstep;
            PG8_LDB(B0, 0, 0); PG8_LDB(B1, 0, 1); PG8_SCHED; PG8_LDA(At, 0, 0); PG8_STAGE(PG8_SA(1, 1), a1 + hstepA, voffA);
            PG8_WAIT_V(8); PG8_WAIT_L(0); PG8_BAR; PG8_MMA(0, 0, At, B0); PG8_MMA(0, 1, At, B1); PG8_BAR; PG8_SCHED;
            PG8_LDA(At, 0, 1); PG8_STAGE(PG8_SB(0, 0), b2, voffB); PG8_STAGE(PG8_SB(0, 1), b2 + hstepB, voffB); PG8_STAGE(PG8_SA(0, 0), a2, voffA);
            PG8_WAIT_V(8); PG8_WAIT_L(0); PG8_BAR; PG8_MMA(1, 0, At, B0); PG8_MMA(1, 1, At, B1); PG8_BAR; PG8_SCHED;
            PG8_LDB(B0, 1, 0); PG8_LDB(B1, 1, 1); PG8_SCHED; PG8_LDA(At, 1, 0); PG8_STAGE(PG8_SA(0, 1), a2 + hstepA, voffA);
            PG8_WAIT_V(8); PG8_WAIT_L(0); PG8_BAR; PG8_MMA(0, 0, At, B0); PG8_MMA(0, 1, At, B1); PG8_BAR; PG8_SCHED;
            PG8_LDA(At, 1, 1); PG8_STAGE(PG8_SB(1, 0), b3, voffB); PG8_STAGE(PG8_SB(1, 1), b3 + hstepB, voffB); PG8_STAGE(PG8_SA(1, 0), a3, voffA);
            PG8_WAIT_V(8); PG8_WAIT_L(0); PG8_BAR; PG8_MMA(1, 0, At, B0); PG8_MMA(1, 1, At, B1); PG8_BAR; PG8_SCHED;
        }
        if (wr == 0) PG8_BAR;
        E(acc, cur, wr, wc, fr, fq);
        if (!has_next) break;
#pragma unroll
        for (int a = 0; a < 2; ++a)
#pragma unroll
            for (int b = 0; b < 2; ++b)
#pragma unroll
                for (int m = 0; m < 4; ++m)
#pragma unroll
                    for (int n = 0; n < 2; ++n) acc[a][b][m][n] = (f32x4){0.f, 0.f, 0.f, 0.f};
        cur = nxt; cA = nA; cB = nB; ++ui; nt = PG8_NT(cur);
        if (wr == 1) PG8_BAR;
    }
    PG8_WAIT_V(0);
    PG8_BAR;
#undef PG8_NT
#undef PG8_SA
#undef PG8_SB
#undef PG8_STAGE
#undef PG8_LDA
#undef PG8_LDB
#undef PG8_MMA
#undef PG8_WAIT_V
#undef PG8_WAIT_L
#undef PG8_BAR
#undef PG8_SCHED
}
}

struct Args { const void* in[24]; float* out; unsigned char* ws; int ph_lo, ph_hi; };
enum { I_X = 0, I_C, I_POS, I_WADA, I_BADA, I_N1G, I_N2G, I_NFG, I_WIN, I_WOUT, I_MU, I_W0, I_WDEC, I_A0, I_WICLR, I_WGATE, I_KK, I_KA, I_RK, I_GNG, I_GNB, I_FG, I_FU, I_FD };

__device__ __forceinline__ void transpose_item(const float* W, int Ksrc, int N, bf16_t* WT, int ldk, int drow0, int k0, int n0, LAS float* scr, int lane) {
    float tv[32];
#pragma unroll
    for (int i = 0; i < 32; ++i) { const int k = k0 + 2 * i + (lane >> 5); tv[i] = (k < Ksrc) ? W[(size_t)k * N + n0 + (lane & 31)] : 0.f; }
#pragma unroll
    for (int i = 0; i < 32; ++i) scr[(2 * i + (lane >> 5)) * 33 + (lane & 31)] = tv[i];
    LDS_WAIT();
    const int c = lane & 7;
#pragma unroll
    for (int j = 0; j < 4; ++j) { const int n = (lane >> 3) + 8 * j; const LAS float* s = scr + (8 * c) * 33 + n;
        u32x4 o; o.x = pk2(s[0 * 33], s[1 * 33]); o.y = pk2(s[2 * 33], s[3 * 33]); o.z = pk2(s[4 * 33], s[5 * 33]); o.w = pk2(s[6 * 33], s[7 * 33]);
        *(u32x4*)(WT + (size_t)(drow0 + n) * ldk + k0 + 8 * c) = o; }
    LDS_WAIT();
}

__device__ __forceinline__ void norm_rows_mod(const float* X, bf16_t* H, const float* gvec, const float* sc, const float* sh, int gw, int NGW, int lane) {
    for (int row = gw; row < T; row += NGW) {
        const int bo = (row >= SEQ) ? ADA_N : 0;
        const f32x4* xr = (const f32x4*)(X + (size_t)row * DM) + lane;
        f32x4 v[8]; float ss = 0.f;
#pragma unroll
        for (int j = 0; j < 8; ++j) { v[j] = xr[64 * j]; ss += (v[j].x * v[j].x + v[j].y * v[j].y) + (v[j].z * v[j].z + v[j].w * v[j].w); }
        const float rstd = 1.0f / sqrtf(wave_sum(ss) * (1.0f / DM) + 1e-6f);
        u32x2* o8 = (u32x2*)(H + (size_t)row * DM) + lane;
#pragma unroll
        for (int j = 0; j < 8; ++j) { const int col = 4 * lane + 256 * j;
            const f32x4 g4 = *(const f32x4*)(gvec + col), s4 = *(const f32x4*)(sc + bo + col), h4 = *(const f32x4*)(sh + bo + col);
            const f32x4 y = (v[j] * rstd) * g4 * (s4 + 1.0f) + h4;
            u32x2 w; w.x = pk2(y.x, y.y); w.y = pk2(y.z, y.w); o8[64 * j] = w; }
    }
}

struct ScanPtrs {
    const bf16_t* proj; const _Float16* lz; const float* kkn;
    const float *mu, *k_k, *k_a, *r_k, *gn_g, *gn_b;
    float* cs; float* sinit; bf16_t* mix;
};
template <int MODE, int TS>
__device__ __forceinline__ void scan_item(LAS float* W, const ScanPtrs& p, int chain, int c, int lane) {
    const int b = chain >> 4, h = chain & 15, hc = h * 64 + lane, rg = lane >> 2, cgi = lane & 3;
    f32x2 su[4][8];
    if (MODE == 2 && c > 0) {
#pragma unroll
        for (int r = 0; r < 4; ++r) { const f32x4* sp = (const f32x4*)(p.sinit + ((size_t)(chain * NCH + c) * 4096 + (4 * rg + r) * 64 + 16 * cgi));
#pragma unroll
            for (int i = 0; i < 4; ++i) { const f32x4 t = sp[i]; su[r][2 * i] = t.xy; su[r][2 * i + 1] = t.zw; } }
    } else {
#pragma unroll
        for (int r = 0; r < 4; ++r)
#pragma unroll
            for (int cc = 0; cc < 8; ++cc) su[r][cc] = (MODE == 1) ? (f32x2){(4 * rg + r == 16 * cgi + 2 * cc) ? 1.f : 0.f, (4 * rg + r == 16 * cgi + 2 * cc + 1) ? 1.f : 0.f} : (f32x2){0.f, 0.f};
    }
    const float mu_r = p.mu[hc], mu_k = p.mu[1024 + hc], mu_v = p.mu[2048 + hc], kkc = p.k_k[hc], kac = p.k_a[hc];
    float rkc = 0.f, gng = 0.f, gnb = 0.f;
    if (MODE == 2) { rkc = p.r_k[hc]; gng = p.gn_g[hc]; gnb = p.gn_b[hc]; }
    const int t0 = c * CL; const size_t row0 = (size_t)b * SEQ + t0;
    float rp = 0.f, kp = 0.f, vp = 0.f;
    if (t0 > 0) { const bf16_t* pr = p.proj + (row0 - 1) * LDP; rp = bf2f(pr[PC_R + hc]); kp = bf2f(pr[PC_RK + hc]); vp = bf2f(pr[PC_RV + hc]); }
    bf16_t qr[TS], qk[TS], qv[TS]; _Float16 qz[TS], qa[TS], qg[TS]; float qn[TS];
#define SCAN_LOAD(sc_) do { _Pragma("unroll") for (int st = 0; st < TS; ++st) { const size_t row = row0 + (sc_) * TS + st; const bf16_t* pr = p.proj + row * LDP; const _Float16* lzr = p.lz + row * 3072 + hc; \
        if (MODE != 1) { qr[st] = pr[PC_R + hc]; qv[st] = pr[PC_RV + hc]; } qk[st] = pr[PC_RK + hc]; qz[st] = lzr[0]; qa[st] = lzr[1024]; if (MODE == 2) qg[st] = lzr[2048]; qn[st] = p.kkn[row * 16 + h]; } } while (0)
    SCAN_LOAD(0);
#pragma unroll 1
    for (int sc = 0; sc < CL / TS; ++sc) {
#pragma unroll
        for (int st = 0; st < TS; ++st) {
            const float kc = bf2f(qk[st]);
            const float k = kc + (kp - kc) * mu_k; kp = kc;
            const float av = (float)qa[st], inv = qn[st];
            const float dec = __expf(-(float)qz[st]);
            const float kk = k * kkc * inv;
            LAS float* V = W + st * 512;
            V[lane] = -kk; V[64 + lane] = dec; V[128 + lane] = kk * av;
            if (MODE != 1) {
                const float rc = bf2f(qr[st]), vc = bf2f(qv[st]);
                const float r = rc + (rp - rc) * mu_r, v = vc + (vp - vc) * mu_v; rp = rc; vp = vc;
                const float kpr = k * (1.0f + (av - 1.0f) * kac);
                V[192 + lane] = kpr; V[320 + lane] = v;
                if (MODE == 2) { V[256 + lane] = r; V[384 + lane] = (float)qg[st]; }
            }
        }
        if (sc + 1 < CL / TS) SCAN_LOAD(sc + 1);
#pragma unroll 4
        for (int st = 0; st < TS; ++st) {
            const LAS float* V = W + st * 512;
            const LAS f32x4* Nq = (const LAS f32x4*)(V + 16 * cgi);
            const LAS f32x4* Dq = (const LAS f32x4*)(V + 64 + 16 * cgi); const LAS f32x4* Bq = (const LAS f32x4*)(V + 128 + 16 * cgi); const LAS f32x4* Kq = (const LAS f32x4*)(V + 192 + 16 * cgi);
            const LAS f32x4* Rq = (const LAS f32x4*)(V + 256 + 16 * cgi);
            f32x4 n4[4], d4[4], b4[4], k4[4], r4[4], v4 = {0.f, 0.f, 0.f, 0.f};
#pragma unroll
            for (int i = 0; i < 4; ++i) n4[i] = Nq[i];
#pragma unroll
            for (int i = 0; i < 4; ++i) { d4[i] = Dq[i]; b4[i] = Bq[i]; if (MODE != 1) k4[i] = Kq[i]; if (MODE == 2) r4[i] = Rq[i]; }
            if (MODE != 1) v4 = *(const LAS f32x4*)(V + 320 + 4 * rg);
            f32x2 au[4];
#pragma unroll
            for (int r = 0; r < 4; ++r) au[r] = (f32x2){0.f, 0.f};
#pragma unroll
            for (int i = 0; i < 4; ++i)
#pragma unroll
                for (int r = 0; r < 4; ++r) { au[r] += su[r][2 * i] * n4[i].xy; au[r] += su[r][2 * i + 1] * n4[i].zw; }
            float sau[4];
#pragma unroll
            for (int r = 0; r < 4; ++r) { float t = au[r].x + au[r].y; t += dpp_mov<0xB1>(t); t += dpp_mov<0x4E>(t); sau[r] = t; }
            f32x2 ao[4];
#pragma unroll
            for (int r = 0; r < 4; ++r) ao[r] = (f32x2){0.f, 0.f};
#pragma unroll
            for (int i = 0; i < 4; ++i) {
#pragma unroll
                for (int r = 0; r < 4; ++r) {
                    if (MODE == 1) { su[r][2 * i] = su[r][2 * i] * d4[i].xy + b4[i].xy * sau[r]; su[r][2 * i + 1] = su[r][2 * i + 1] * d4[i].zw + b4[i].zw * sau[r]; }
                    else { su[r][2 * i] = su[r][2 * i] * d4[i].xy + b4[i].xy * sau[r] + k4[i].xy * v4[r]; su[r][2 * i + 1] = su[r][2 * i + 1] * d4[i].zw + b4[i].zw * sau[r] + k4[i].zw * v4[r]; }
                    if (MODE == 2) { ao[r] += su[r][2 * i] * r4[i].xy; ao[r] += su[r][2 * i + 1] * r4[i].zw; }
                }
            }
            if (MODE == 2) {
                float o[4];
#pragma unroll
                for (int r = 0; r < 4; ++r) { float t = ao[r].x + ao[r].y; t += dpp_mov<0xB1>(t); t += dpp_mov<0x4E>(t); o[r] = t; }
                const float osel = (cgi == 0) ? o[0] : (cgi == 1) ? o[1] : (cgi == 2) ? o[2] : o[3];
                W[st * 512 + 128 + lane] = osel;
            }
        }
        if (MODE == 2) {
            const int pst = lane >> 3, pc = (lane & 7) * 8;
            const LAS float* V = W + pst * 512;
            const f32x4 x0 = *(const LAS f32x4*)(V + 128 + pc), x1 = *(const LAS f32x4*)(V + 128 + pc + 4);
            float sm = ((x0.x + x0.y) + (x0.z + x0.w)) + ((x1.x + x1.y) + (x1.z + x1.w));
            sm += dpp_mov<0xB1>(sm); sm += dpp_mov<0x4E>(sm); sm += dpp_mov<0x141>(sm);
            const float mean = sm * (1.0f / 64.0f);
            const f32x4 d0 = x0 - mean, d1 = x1 - mean;
            float sq = ((d0.x * d0.x + d0.y * d0.y) + (d0.z * d0.z + d0.w * d0.w)) + ((d1.x * d1.x + d1.y * d1.y) + (d1.z * d1.z + d1.w * d1.w));
            sq += dpp_mov<0xB1>(sq); sq += dpp_mov<0x4E>(sq); sq += dpp_mov<0x141>(sq);
            const float rstd = __builtin_amdgcn_rsqf(sq * (1.0f / 64.0f) + 64e-5f);
            const f32x4 g0 = *(const f32x4*)(p.gn_g + h * 64 + pc), g1 = *(const f32x4*)(p.gn_g + h * 64 + pc + 4), b0 = *(const f32x4*)(p.gn_b + h * 64 + pc), b1 = *(const f32x4*)(p.gn_b + h * 64 + pc + 4);
            const f32x4 v0 = *(const LAS f32x4*)(V + 320 + pc), v1 = *(const LAS f32x4*)(V + 320 + pc + 4), q0 = *(const LAS f32x4*)(V + 384 + pc), q1 = *(const LAS f32x4*)(V + 384 + pc + 4);
            const f32x4 r0 = *(const LAS f32x4*)(V + 256 + pc), r1 = *(const LAS f32x4*)(V + 256 + pc + 4), k0_ = *(const LAS f32x4*)(V + 192 + pc), k1_ = *(const LAS f32x4*)(V + 192 + pc + 4);
            const f32x4 c0 = *(const f32x4*)(p.r_k + h * 64 + pc), c1 = *(const f32x4*)(p.r_k + h * 64 + pc + 4);
            const f32x4 t0 = r0 * k0_ * c0, t1 = r1 * k1_ * c1;
            float rk = ((t0.x + t0.y) + (t0.z + t0.w)) + ((t1.x + t1.y) + (t1.z + t1.w));
            rk += dpp_mov<0xB1>(rk); rk += dpp_mov<0x4E>(rk); rk += dpp_mov<0x141>(rk);
            const f32x4 y0 = ((d0 * rstd) * g0 + b0 + v0 * rk) * q0, y1 = ((d1 * rstd) * g1 + b1 + v1 * rk) * q1;
            u32x4 wv; wv.x = pk2hw(y0.x, y0.y); wv.y = pk2hw(y0.z, y0.w); wv.z = pk2hw(y1.x, y1.y); wv.w = pk2hw(y1.z, y1.w);
            const size_t row = row0 + sc * TS + pst;
            *(u32x4*)(p.mix + row * DM + 1024 + h * 64 + pc) = wv;
        }
    }
#undef SCAN_LOAD
    if (MODE != 2) {
#pragma unroll
        for (int r = 0; r < 4; ++r) {
            f32x4* du = (f32x4*)(p.cs + ((size_t)((chain * NCH + c) * 2 + MODE) * 4096 + (4 * rg + r) * 64 + 16 * cgi));
#pragma unroll
            for (int i = 0; i < 4; ++i) du[i] = (f32x4){su[r][2 * i].x, su[r][2 * i].y, su[r][2 * i + 1].x, su[r][2 * i + 1].y};
        }
    }
}

__device__ __forceinline__ void scan_combine(LAS float* L, const float* cs, float* sinit, int chain, int tid) {
#define SC_LDS_BARRIER() do { asm volatile("s_waitcnt lgkmcnt(0)" ::: "memory"); __builtin_amdgcn_s_barrier(); asm volatile("" ::: "memory"); } while (0)
    LAS float* Sl = L; LAS float* Pl = L + 64 * 68;
    const int i = tid & 63, w8 = __builtin_amdgcn_readfirstlane(tid >> 6);
    const float* base = cs + (size_t)(chain * NCH) * 2 * 4096;
    f32x4 pP0 = *(const f32x4*)(base + 4096 + tid * 8), pP1 = *(const f32x4*)(base + 4096 + tid * 8 + 4);
    f32x4 pU0 = *(const f32x4*)(base + i * 64 + 8 * w8), pU1 = *(const f32x4*)(base + i * 64 + 8 * w8 + 4);
    f32x4 a0 = {0.f, 0.f, 0.f, 0.f}, a1 = {0.f, 0.f, 0.f, 0.f};
#pragma unroll 1
    for (int c = 0; c < NCH - 1; ++c) {
        *(LAS f32x4*)(Sl + i * 68 + 8 * w8) = a0; *(LAS f32x4*)(Sl + i * 68 + 8 * w8 + 4) = a1;
        *(LAS f32x4*)(Pl + tid * 8) = pP0; *(LAS f32x4*)(Pl + tid * 8 + 4) = pP1;
        f32x4 u0 = pU0, u1 = pU1;
        SC_LDS_BARRIER();
        if (c + 1 < NCH - 1) { const float* nb = base + (size_t)(c + 1) * 2 * 4096;
            pP0 = *(const f32x4*)(nb + 4096 + tid * 8); pP1 = *(const f32x4*)(nb + 4096 + tid * 8 + 4);
            pU0 = *(const f32x4*)(nb + i * 64 + 8 * w8); pU1 = *(const f32x4*)(nb + i * 64 + 8 * w8 + 4); }
        f32x4 srow[16];
#pragma unroll
        for (int k = 0; k < 16; ++k) srow[k] = *(const LAS f32x4*)(Sl + i * 68 + 4 * k);
#pragma unroll
        for (int j = 0; j < 64; ++j) { const float sij = srow[j >> 2][j & 3];
            const f32x4 p0 = *(const LAS f32x4*)(Pl + j * 64 + 8 * w8), p1 = *(const LAS f32x4*)(Pl + j * 64 + 8 * w8 + 4); u0 += p0 * sij; u1 += p1 * sij; }
        a0 = u0; a1 = u1;
        SC_LDS_BARRIER();
        float* so = sinit + (size_t)(chain * NCH + c + 1) * 4096 + i * 64 + 8 * w8;
        *(f32x4*)so = a0; *(f32x4*)(so + 4) = a1;
    }
#undef SC_LDS_BARRIER
}

constexpr int KS_STRIDE = 72, VT_STRIDE = 288;
constexpr int ATT_KS_OFF = 0, ATT_VT_OFF = 256 * KS_STRIDE * 2;
constexpr int ATT_UNITS = 12288;
struct AttnUnit { int b, h, g, dl, res, n, u; };
__device__ __forceinline__ AttnUnit attn_decode(int u) {
    AttnUnit a; a.u = u; const int bh = u / 384, rest = u % 384; a.g = rest / 128; const int rn = rest % 128;
    a.b = bh >> 4; a.h = bh & 15; a.dl = (a.g == 0) ? 1 : (a.g == 1 ? 4 : 16);
    const int nbk = 128 / a.dl; a.res = rn / nbk; a.n = rn % nbk; return a;
}
__device__ __forceinline__ void attn_load(const AttnUnit& a, const bf16_t* proj, int tid, u32x4 (&kv)[4], u32x4 (&vv)[4]) {
#pragma unroll
    for (int ps = 0; ps < 4; ++ps) {
        const int idx = ps * 512 + tid, key = idx >> 3, seg = idx & 7;
        const int sub = (a.n - 1) * 128 + key, subc = sub < 0 ? 0 : sub;
        const size_t row = (size_t)a.b * SEQ + (size_t)subc * a.dl + a.res; const bf16_t* pr = proj + row * LDP + a.h * 64 + seg * 8;
        kv[ps] = *(const u32x4*)(pr + PC_K); vv[ps] = *(const u32x4*)(pr + PC_V);
    }
}
__device__ __forceinline__ void attn_stage(LAS unsigned char* lds, int tid, int n, const u32x4 (&kv)[4], const u32x4 (&vv)[4]) {
    LAS bf16_t* Ks = (LAS bf16_t*)(lds + ATT_KS_OFF);
    LAS bf16_t* Vt = (LAS bf16_t*)(lds + ATT_VT_OFF);
#pragma unroll
    for (int ps = 0; ps < 4; ++ps) {
        const int idx = ps * 512 + tid, key = idx >> 3, seg = idx & 7;
        u32x4 k4 = kv[ps], v4 = vv[ps];
        if (n == 0 && ps < 2) { k4 = (u32x4){0u, 0u, 0u, 0u}; v4 = (u32x4){0u, 0u, 0u, 0u}; }
        *(LAS u32x4*)(Ks + key * KS_STRIDE + seg * 8) = k4;
        LAS bf16_t* vd = Vt + (seg * 8) * VT_STRIDE + (key ^ (seg << 2));
        vd[0 * VT_STRIDE] = (bf16_t)(v4.x & 0xffffu); vd[1 * VT_STRIDE] = (bf16_t)(v4.x >> 16);
        vd[2 * VT_STRIDE] = (bf16_t)(v4.y & 0xffffu); vd[3 * VT_STRIDE] = (bf16_t)(v4.y >> 16);
        vd[4 * VT_STRIDE] = (bf16_t)(v4.z & 0xffffu); vd[5 * VT_STRIDE] = (bf16_t)(v4.z >> 16);
        vd[6 * VT_STRIDE] = (bf16_t)(v4.w & 0xffffu); vd[7 * VT_STRIDE] = (bf16_t)(v4.w >> 16);
    }
}
struct AttnOut { unsigned c01[4], c23[4]; float lsev; };
__device__ __forceinline__ void attn_compute(LAS unsigned char* lds, const AttnUnit& a, const bf16x8 (&qf)[2], AttnOut& o, int tid) {
    const int lane = tid & 63, w = __builtin_amdgcn_readfirstlane(tid >> 6), r = lane & 15, q = lane >> 4;
    const int n = a.n, dl = a.dl, res = a.res, b = a.b, h = a.h, g = a.g;
    const LAS bf16_t* Ks = (const LAS bf16_t*)(lds + ATT_KS_OFF);
    const LAS bf16_t* Vt = (const LAS bf16_t*)(lds + ATT_VT_OFF);
    f32x4 sacc[9];
#pragma unroll
    for (int kt = 0; kt < 9; ++kt) {
        sacc[kt] = (f32x4){0.f, 0.f, 0.f, 0.f};
#pragma unroll
        for (int ks = 0; ks < 2; ++ks) {
            const bf16x8 kf = *(const LAS bf16x8*)(Ks + (16 * w + 16 * kt + r) * KS_STRIDE + 32 * ks + 8 * q);
            sacc[kt] = __builtin_amdgcn_mfma_f32_16x16x32_bf16(kf, qf[ks], sacc[kt], 0, 0, 0);
        }
    }
    float mx = -INFINITY;
#pragma unroll
    for (int j = 0; j < 4; ++j) { if (4 * q + j < r) sacc[0][j] = -INFINITY; if (4 * q + j > r) sacc[8][j] = -INFINITY; }
    if (n == 0) {
#pragma unroll
        for (int kt = 0; kt < 8; ++kt)
#pragma unroll
            for (int j = 0; j < 4; ++j) if (16 * w + 16 * kt + 4 * q + j < 128) sacc[kt][j] = -INFINITY;
    }
#pragma unroll
    for (int kt = 0; kt < 9; ++kt)
#pragma unroll
        for (int j = 0; j < 4; ++j) mx = fmaxf(mx, sacc[kt][j]);
    mx = fmaxf(mx, __shfl_xor(mx, 16)); mx = fmaxf(mx, __shfl_xor(mx, 32));
    float lsum = 0.f;
    const float mxl = mx * 1.44269504f;
#pragma unroll
    for (int kt = 0; kt < 9; ++kt)
#pragma unroll
        for (int j = 0; j < 4; ++j) { const float pv = __builtin_amdgcn_exp2f(__builtin_fmaf(sacc[kt][j], 1.44269504f, -mxl)); sacc[kt][j] = pv; lsum += pv; }
    lsum += __shfl_xor(lsum, 16); lsum += __shfl_xor(lsum, 32);
    const LAS bf16_t* vlo[4]; const LAS bf16_t* vhi[4];
#pragma unroll
    for (int dt = 0; dt < 4; ++dt) { const int d = 16 * dt + r, sw = (d >> 3) << 2, kb = 16 * w + 4 * q;
        vlo[dt] = Vt + d * VT_STRIDE + (kb ^ sw); vhi[dt] = Vt + d * VT_STRIDE + ((kb + 16) ^ sw); }
    f32x4 oacc[4];
#pragma unroll
    for (int dt = 0; dt < 4; ++dt) oacc[dt] = (f32x4){0.f, 0.f, 0.f, 0.f};
#pragma unroll
    for (int kp = 0; kp < 5; ++kp) {
        u32x4 pw;
        pw.x = pk2hw(sacc[2 * kp][0], sacc[2 * kp][1]); pw.y = pk2hw(sacc[2 * kp][2], sacc[2 * kp][3]);
        if (kp < 4) { pw.z = pk2hw(sacc[2 * kp + 1][0], sacc[2 * kp + 1][1]); pw.w = pk2hw(sacc[2 * kp + 1][2], sacc[2 * kp + 1][3]); } else { pw.z = 0u; pw.w = 0u; }
        const bf16x8 pf = __builtin_bit_cast(bf16x8, pw);
#pragma unroll
        for (int dt = 0; dt < 4; ++dt) {
            const s16x4 lo = *(const LAS s16x4*)(vlo[dt] + 32 * kp), hi = *(const LAS s16x4*)(vhi[dt] + 32 * kp);
            const bf16x8 vf = __builtin_shufflevector(lo, hi, 0, 1, 2, 3, 4, 5, 6, 7);
            oacc[dt] = __builtin_amdgcn_mfma_f32_16x16x32_bf16(pf, vf, oacc[dt], 0, 0, 0);
        }
    }
    const float linv = __builtin_amdgcn_rcpf(lsum);
#pragma unroll
    for (int j = 0; j < 4; ++j) {
        const float li = __shfl(linv, 4 * q + j);
        o.c01[j] = pk2hw(oacc[0][j] * li, oacc[1][j] * li); o.c23[j] = pk2hw(oacc[2][j] * li, oacc[3][j] * li);
    }
    o.lsev = mx + __logf(lsum);
}
__device__ __forceinline__ void attn_store(const AttnUnit& a, const AttnOut& o, bf16_t* op01, bf16_t* op2, float* lse, int tid) {
    const int lane = tid & 63, w = __builtin_amdgcn_readfirstlane(tid >> 6), r = lane & 15, q = lane >> 4;
    bf16_t* ob = (a.g == 2) ? op2 : (op01 + (size_t)a.g * T * 1024);
#pragma unroll
    for (int j = 0; j < 4; ++j) {
        const int qs2 = a.n * 128 + 16 * w + 4 * q + j;
        const size_t orow = (size_t)a.b * SEQ + (size_t)qs2 * a.dl + a.res;
        bf16_t* op_ = ob + orow * 1024 + a.h * 64 + r;
        op_[0] = (bf16_t)(o.c01[j] & 0xffffu); op_[16] = (bf16_t)(o.c01[j] >> 16); op_[32] = (bf16_t)(o.c23[j] & 0xffffu); op_[48] = (bf16_t)(o.c23[j] >> 16);
    }
    if (q == 0) lse[(size_t)a.u * 128 + 16 * w + r] = o.lsev;
}
__device__ __forceinline__ void attn_phase(LAS unsigned char* lds, int ubeg, int ustride, int ucnt, const bf16_t* proj, bf16_t* op01, bf16_t* op2, float* lse, int tid) {
#define ATT_LDS_BARRIER() do { asm volatile("s_waitcnt lgkmcnt(0)" ::: "memory"); __builtin_amdgcn_s_barrier(); asm volatile("" ::: "memory"); } while (0)
    LAS bf16_t* Vt = (LAS bf16_t*)(lds + ATT_VT_OFF);
    const int lane = tid & 63, w = __builtin_amdgcn_readfirstlane(tid >> 6), r = lane & 15, q = lane >> 4;
    for (int idx = tid; idx < 64 * 16; idx += 512) { const int d = idx >> 4, cc = idx & 15; *(LAS unsigned*)(Vt + d * VT_STRIDE + 256 + 2 * cc) = 0u; }
    __syncthreads();
    if (ucnt <= 0) return;
    u32x4 kv[4], vv[4]; bf16x8 qn[2];
#define ATT_LOADQ(dst, au) do { const size_t qrow_ = (size_t)(au).b * SEQ + (size_t)((au).n * 128 + 16 * w + r) * (au).dl + (au).res; \
        dst[0] = *(const bf16x8*)(proj + qrow_ * LDP + PC_Q + (au).h * 64 + 8 * q); dst[1] = *(const bf16x8*)(proj + qrow_ * LDP + PC_Q + (au).h * 64 + 32 + 8 * q); } while (0)
    { const AttnUnit a0 = attn_decode(ubeg); ATT_LOADQ(qn, a0); attn_load(a0, proj, tid, kv, vv); }
    AttnOut o;
#pragma unroll
    for (int j = 0; j < 4; ++j) { o.c01[j] = 0u; o.c23[j] = 0u; }
    o.lsev = 0.f;
    for (int i = 0; i < ucnt; ++i) {
        const AttnUnit a0 = attn_decode(ubeg + i * ustride);
        attn_stage(lds, tid, a0.n, kv, vv);
        if (i > 0) { const AttnUnit ap = attn_decode(ubeg + (i - 1) * ustride); attn_store(ap, o, op01, op2, lse, tid); }
        bf16x8 qf[2]; qf[0] = qn[0]; qf[1] = qn[1];
        { const int inext = (i + 1 < ucnt) ? i + 1 : i; const AttnUnit a1 = attn_decode(ubeg + inext * ustride); ATT_LOADQ(qn, a1); attn_load(a1, proj, tid, kv, vv); }
        ATT_LDS_BARRIER();
        attn_compute(lds, a0, qf, o, tid);
        ATT_LDS_BARRIER();
    }
    { const AttnUnit ap = attn_decode(ubeg + (ucnt - 1) * ustride); attn_store(ap, o, op01, op2, lse, tid); }
#undef ATT_LDS_BARRIER
#undef ATT_LOADQ
    __syncthreads();
}

__global__ void __launch_bounds__(512, 2) mk_fwd(Args a) {
    extern __shared__ __attribute__((aligned(16))) unsigned char lds_raw[];
    cg::grid_group grid = cg::this_grid();
    LAS unsigned char* lds = (LAS unsigned char*)lds_raw;
    const int G = gridDim.x, bx = blockIdx.x;
    const int NGW = G * 8, NGT = G * 512;
#define PH_IDS const int tid = opaque_tid(wave_s), lane = tid & 63, wave = wave_s, gw = bx * 8 + wave, gt = bx * 512 + tid; (void)lane; (void)gw; (void)gt; (void)wave; PH_WS
#define PH_WS __attribute__((address_space(1))) unsigned char* ws = (__attribute__((address_space(1))) unsigned char*)a.ws; asm volatile("" : "+s"(ws)); float* const outp = a.out
#define ctl ((unsigned*)(ws + WS_CTL))
#define x_in ((const float*)a.in[I_X])
#define adap ((float*)(ws + WS_ADAP))
#define ada ((float*)(ws + WS_ADA))
#define rope ((float*)(ws + WS_ROPE))
#define kkn ((float*)(ws + WS_KKN))
#define lse ((float*)(ws + WS_LSE))
#define WdT ((bf16_t*)(ws + WS_WLORA))
#define WaT (WdT + 1024 * 256)
#define WgT (WdT + 2 * 1024 * 256)
#define WinT ((bf16_t*)(ws + WS_WIN))
#define WoutT ((bf16_t*)(ws + WS_WOUT))
#define WguT ((bf16_t*)(ws + WS_WGU))
#define WdownT ((bf16_t*)(ws + WS_WDOWN))
#define lact ((bf16_t*)(ws + WS_LACT))
#define cs ((float*)(ws + WS_CS))
#define sinit ((float*)(ws + WS_SINIT))
#define proj ((bf16_t*)(ws + WS_PROJ))
#define hid ((bf16_t*)(ws + WS_PROJ))
#define hbuf ((bf16_t*)(ws + WS_HBUF))
#define mix ((bf16_t*)(ws + WS_MIX))
#define op2 ((bf16_t*)(ws + WS_OP2))
#define lz ((_Float16*)outp)
#define lbias ((float*)(ws + WS_ADA + 512 * 1024))
#define IN(k) (a.ph_lo <= (k) && (k) < a.ph_hi)
#ifndef MK_PROBE
#define MK_PROBE -1
#endif
#define REPS(k) for (int rep_ = 0; rep_ < ((MK_PROBE == (k)) ? 2 : 1); ++rep_)
    volatile LAS unsigned* bst = (volatile LAS unsigned*)(lds + 140032);
    const int wave_s = __builtin_amdgcn_readfirstlane((int)threadIdx.x >> 6);
    if (threadIdx.x == 0) { bst[0] = 0u; bst[1] = 0u; }
    __syncthreads();
    XcdBarrier xbar; xbar.bar = (unsigned*)(a.ws + WS_CTL) + 4096; xbar.x = 0; xbar.st = bst;
    if (a.ph_hi - a.ph_lo > 1) xbar = xcd_barrier_post((unsigned*)(a.ws + WS_CTL) + 4096, bst, threadIdx.x == 0);
#define SYNC(k) do { if (IN(k) && IN((k) + 1)) { if ((k) == 0) grid.sync(); else xcd_barrier(xbar, wave_s); } } while (0)

    if (IN(0)) {
        PH_IDS;
        LAS float* scr = (LAS float*)(lds + wave * 16384);
        constexpr int I_IN = 32 * 201, I_OUT = 32 * 64, I_G = 32 * 176, I_D = 88 * 64, I_LD = 4 * 32, I_LG = 4 * 32;
        constexpr int NITEMS = I_IN + I_OUT + 2 * I_G + I_D + 2 * I_LD + I_LG;
        for (int it = gw; it < NITEMS; it += NGW) {
            int r_ = it;
            if (r_ < I_IN) { const int kb = r_ / 201, nb = r_ % 201; transpose_item((const float*)a.in[I_WIN], DM, NPROJ, WinT, DM, 32 * nb, 64 * kb, 32 * nb, scr, lane); continue; } r_ -= I_IN;
            if (r_ < I_OUT) { const int kb = r_ / 64, nb = r_ % 64; transpose_item((const float*)a.in[I_WOUT], DM, DM, WoutT, DM, 32 * nb, 64 * kb, 32 * nb, scr, lane); continue; } r_ -= I_OUT;
            if (r_ < I_G) { const int kb = r_ / 176, nb = r_ % 176, n0 = 32 * nb; transpose_item((const float*)a.in[I_FG], DM, FF, WguT, DM, 256 * (n0 / 128) + (n0 % 128), 64 * kb, n0, scr, lane); continue; } r_ -= I_G;
            if (r_ < I_G) { const int kb = r_ / 176, nb = r_ % 176, n0 = 32 * nb; transpose_item((const float*)a.in[I_FU], DM, FF, WguT, DM, 256 * (n0 / 128) + 128 + (n0 % 128), 64 * kb, n0, scr, lane); continue; } r_ -= I_G;
            if (r_ < I_D) { const int kb = r_ / 64, nb = r_ % 64; transpose_item((const float*)a.in[I_FD], FF, DM, WdownT, FF, 32 * nb, 64 * kb, 32 * nb, scr, lane); continue; } r_ -= I_D;
            if (r_ < I_LD) { const int kb = r_ / 32, nb = r_ % 32; transpose_item((const float*)a.in[I_WDEC], 64, 1024, WdT, 256, 32 * nb, 64 * kb, 32 * nb, scr, lane); continue; } r_ -= I_LD;
            if (r_ < I_LD) { const int kb = r_ / 32, nb = r_ % 32; transpose_item((const float*)a.in[I_WICLR], 64, 1024, WaT, 256, 32 * nb, 64 * kb, 32 * nb, scr, lane); continue; } r_ -= I_LD;
            { const int kb = r_ / 32, nb = r_ % 32; transpose_item((const float*)a.in[I_WGATE], 160, 1024, WgT, 256, 32 * nb, 64 * kb, 32 * nb, scr, lane); }
        }
        { u32x4* z = (u32x4*)(WinT + (size_t)NPROJ * DM); for (int idx = gt; idx < (LDP - NPROJ) * DM * 2 / 16; idx += NGT) z[idx] = (u32x4){0u, 0u, 0u, 0u}; }
        for (int idx = gt; idx < 3072; idx += NGT) lbias[idx] = (idx < 1024) ? ((const float*)a.in[I_W0])[idx] : (idx < 2048) ? ((const float*)a.in[I_A0])[idx - 1024] : 0.f;
        {
            const float* wada = (const float*)a.in[I_WADA]; const float* cvec = (const float*)a.in[I_C];
            for (int it = bx; it < 768; it += G) {
                const int ks = it / 6, cb = it % 6, n = cb * 2048 + tid * 4;
                f32x4 s0 = {0.f, 0.f, 0.f, 0.f}, s1 = {0.f, 0.f, 0.f, 0.f};
#pragma unroll
                for (int kk = 0; kk < 16; ++kk) { const int k = ks * 16 + kk; const f32x4 wv = *(const f32x4*)(wada + (size_t)k * ADA_N + n);
                    const float c0 = cvec[k], c1 = cvec[DM + k]; const float e0 = c0 * sigmoidf_(c0), e1 = c1 * sigmoidf_(c1); s0 += wv * e0; s1 += wv * e1; }
                *(f32x4*)(adap + (size_t)(ks * 2 + 0) * ADA_N + n) = s0; *(f32x4*)(adap + (size_t)(ks * 2 + 1) * ADA_N + n) = s1;
            }
        }
        {
            const int* pos = (const int*)a.in[I_POS];
            for (int idx = gt; idx < T * 8; idx += NGT) {
                const int row = idx >> 3, i = idx & 7;
                const float inv = (float)exp(-(double)i * 0.125 * 13.122363377404328);
                const float ang = (float)pos[row] * inv;
                const double ad = (double)ang; const double nq = rint(ad * 0.6366197723675814); const double rr = ad - nq * 1.5707963267948966; const double r2 = rr * rr;
                const double sn = rr * (1.0 + r2 * (-1.0 / 6 + r2 * (1.0 / 120 + r2 * (-1.0 / 5040 + r2 * (1.0 / 362880 + r2 * (-1.0 / 39916800 + r2 * (1.0 / 6227020800.0)))))));
                const double cn = 1.0 + r2 * (-0.5 + r2 * (1.0 / 24 + r2 * (-1.0 / 720 + r2 * (1.0 / 40320 + r2 * (-1.0 / 3628800 + r2 * (1.0 / 479001600 + r2 * (-1.0 / 87178291200.0)))))));
                const int qd = ((int)nq) & 3;
                const double cv = (qd == 0) ? cn : (qd == 1) ? -sn : (qd == 2) ? -cn : sn;
                const double sv = (qd == 0) ? sn : (qd == 1) ? cn : (qd == 2) ? -sn : -cn;
                rope[(size_t)row * 16 + i] = (float)cv; rope[(size_t)row * 16 + 8 + i] = (float)sv;
            }
        }
    }
    SYNC(0);
    if (IN(1)) {
        PH_IDS;
        const float* bada = (const float*)a.in[I_BADA];
        for (int id4 = gt; id4 < 4 * 2 * ADA_N; id4 += NGT) {
            const int idx = id4 >> 2, part = id4 & 3, b = idx / ADA_N, n = idx % ADA_N;
            float s0 = 0.f, s1 = 0.f, s2 = 0.f, s3 = 0.f;
#pragma unroll
            for (int k = 0; k < 32; k += 4) {
                s0 += adap[(size_t)((part * 32 + k + 0) * 2 + b) * ADA_N + n]; s1 += adap[(size_t)((part * 32 + k + 1) * 2 + b) * ADA_N + n];
                s2 += adap[(size_t)((part * 32 + k + 2) * 2 + b) * ADA_N + n]; s3 += adap[(size_t)((part * 32 + k + 3) * 2 + b) * ADA_N + n]; }
            float sm = (s0 + s1) + (s2 + s3);
            sm += __shfl_xor(sm, 1); sm += __shfl_xor(sm, 2);
            if (part == 0) ada[idx] = sm + bada[n];
        }
    }
    SYNC(1);
    if (IN(2)) { PH_IDS; norm_rows_mod(x_in, hbuf, (const float*)a.in[I_N1G], ada + 1 * DM, ada + 0 * DM, gw, NGW, lane); }
    SYNC(2);
    REPS(3) if (IN(3)) {
        PH_WS;
        pg8::Gemm g{hbuf, WinT, T, LDP, DM, DM, DM, 0, 0}; pg8::StaticOrder S; S.init(T, LDP, G, bx);
        pg8::EpiProj E{proj, LDP, rope};
        pg8::gemm_phase<pg8::EpiProj, pg8::StaticOrder>(lds, g, S, E, wave_s);
    }
    SYNC(3);
    if (IN(4)) {
        PH_IDS;
        const float* mu = (const float*)a.in[I_MU]; const float* k_k = (const float*)a.in[I_KK];
        for (int row = gw; row < T; row += NGW) {
            const bool first = (row % SEQ) == 0;
            const bf16_t* pr = proj + (size_t)row * LDP; const bf16_t* pp = pr - LDP;
            { const int c0 = 16 * lane; float ss = 0.f;
              const u32x4 k0 = *(const u32x4*)(pr + PC_RK + c0), k1 = *(const u32x4*)(pr + PC_RK + c0 + 8);
              u32x4 p0 = {0u, 0u, 0u, 0u}, p1 = {0u, 0u, 0u, 0u};
              if (!first) { p0 = *(const u32x4*)(pp + PC_RK + c0); p1 = *(const u32x4*)(pp + PC_RK + c0 + 8); }
#pragma unroll
              for (int e = 0; e < 16; ++e) {
                  const unsigned cw = (e < 8) ? k0[e >> 1] : k1[(e - 8) >> 1], pw = (e < 8) ? p0[e >> 1] : p1[(e - 8) >> 1];
                  const float kc = (e & 1) ? __uint_as_float(cw & 0xffff0000u) : __uint_as_float(cw << 16);
                  const float kp = (e & 1) ? __uint_as_float(pw & 0xffff0000u) : __uint_as_float(pw << 16);
                  const float k = kc + (kp - kc) * mu[1024 + c0 + e];
                  const float t = k * k_k[c0 + e]; ss += t * t; }
              ss += __shfl_xor(ss, 1); ss += __shfl_xor(ss, 2);
              if ((lane & 3) == 0) kkn[(size_t)row * 16 + (lane >> 2)] = 1.0f / fmaxf(sqrtf(ss), 1e-12f); }
#pragma unroll
            for (int i = 0; i < 12; ++i) {
                const int d = lane + 64 * i; int src = -1, mode = 0;
                if (d < 64) { src = PC_WL + d; mode = 0; } else if (d >= 256 && d < 320) { src = PC_AL + (d - 256); mode = 1; } else if (d >= 512 && d < 672) { src = PC_GL + (d - 512); mode = 2; }
                float val = 0.f;
                if (src >= 0) { const float yc = bf2f(pr[src]); const float yp = first ? 0.f : bf2f(pp[src]); const float y = yc + (yp - yc) * mu[src - 3072];
                    val = (mode == 0) ? tanhf(y) : (mode == 1) ? y : sigmoidf_(y); }
                lact[(size_t)row * 768 + d] = (bf16_t)f2bf(val);
            }
        }
    }
    SYNC(4);
    if (IN(5)) {
        PH_WS; pg8::StaticOrder S; S.init(T, 3072, G, bx);
        pg8::Gemm g{lact, WdT, T, 3072, 256, 768, 256, 256, 128};
        pg8::EpiLora E{lz, lbias};
        pg8::gemm_phase<pg8::EpiLora, pg8::StaticOrder>(lds, g, S, E, wave_s);
    }
    SYNC(5);
#define MK_SCANPTRS ScanPtrs sp{proj, lz, kkn, (const float*)a.in[I_MU], (const float*)a.in[I_KK], (const float*)a.in[I_KA], (const float*)a.in[I_RK], (const float*)a.in[I_GNG], (const float*)a.in[I_GNB], cs, sinit, mix}
    REPS(6) if (IN(6)) {
        PH_IDS; MK_SCANPTRS;
        LAS float* W = (LAS float*)(lds + wave * 16384);
        for (int it = gw; it < 2 * NCHAIN * NCH; it += NGW) { const int which = it / (NCHAIN * NCH), cc = it % (NCHAIN * NCH);
            if (which == 0) scan_item<0, 8>(W, sp, cc / NCH, cc % NCH, lane); else scan_item<1, 8>(W, sp, cc / NCH, cc % NCH, lane); }
    }
    SYNC(6);
    REPS(7) if (IN(7)) {
        PH_IDS;
        if (bx < NCHAIN) { scan_combine((LAS float*)lds, cs, sinit, bx, tid); __syncthreads(); }
        int ubeg, ustride, ucnt;
        if (G == 256) { const int j = bx - NCHAIN;
            if (bx < NCHAIN) { ubeg = 192 * 51 + 32 * 50 + bx * 28; ucnt = 28; } else if (j < 192) { ubeg = j * 51; ucnt = 51; } else { ubeg = 192 * 51 + (j - 192) * 50; ucnt = 50; } ustride = 1; }
        else { ubeg = bx; ustride = G; ucnt = (ATT_UNITS - bx + G - 1) / G; }
        attn_phase(lds, ubeg, ustride, ucnt, proj, hbuf, op2, lse, tid);
    }
    SYNC(7);
    REPS(8) if (IN(8)) {
        PH_IDS; MK_SCANPTRS;
        LAS float* W = (LAS float*)(lds + wave * 16384);
        for (int it = gw; it < NCHAIN * NCH; it += NGW) scan_item<2, 8>(W, sp, it / NCH, it % NCH, lane);
        const int gt2 = bx * 512 + opaque_tid(wave_s);
        for (int idx0 = gt2; idx0 < T * 128; idx0 += 4 * NGT) {
            float l0[4], l1[4], l2[4]; u32x4 o0[4], o1[4], o2[4];
#pragma unroll
            for (int k = 0; k < 4; ++k) {
                const int idx = idx0 + k * NGT; const int row = idx >> 7, c8 = idx & 127, h = c8 >> 3;
                const int bb_ = row / SEQ, s_ = row % SEQ, ub_ = (bb_ * 16 + h) * 384;
                l0[k] = lse[(size_t)(ub_ + 0 * 128 + (s_ >> 7)) * 128 + (s_ & 127)];
                l1[k] = lse[(size_t)(ub_ + 1 * 128 + (s_ & 3) * 32 + (s_ >> 9)) * 128 + ((s_ >> 2) & 127)];
                l2[k] = lse[(size_t)(ub_ + 2 * 128 + (s_ & 15) * 8 + (s_ >> 11)) * 128 + ((s_ >> 4) & 127)];
                o0[k] = *(const u32x4*)(hbuf + (size_t)row * 1024 + c8 * 8); o1[k] = *(const u32x4*)(hbuf + (size_t)T * 1024 + (size_t)row * 1024 + c8 * 8); o2[k] = *(const u32x4*)(op2 + (size_t)row * 1024 + c8 * 8);
            }
#pragma unroll
            for (int k = 0; k < 4; ++k) {
                const int idx = idx0 + k * NGT; const int row = idx >> 7, c8 = idx & 127;
                const float mxl = fmaxf(l0[k], fmaxf(l1[k], l2[k]));
                float w0 = __expf(l0[k] - mxl), w1 = __expf(l1[k] - mxl), w2 = __expf(l2[k] - mxl); const float wi = 1.0f / (w0 + w1 + w2); w0 *= wi; w1 *= wi; w2 *= wi;
                u32x4 ov;
#pragma unroll
                for (int e = 0; e < 4; ++e) {
                    const float lo = w0 * __uint_as_float(o0[k][e] << 16) + w1 * __uint_as_float(o1[k][e] << 16) + w2 * __uint_as_float(o2[k][e] << 16);
                    const float hi = w0 * __uint_as_float(o0[k][e] & 0xffff0000u) + w1 * __uint_as_float(o1[k][e] & 0xffff0000u) + w2 * __uint_as_float(o2[k][e] & 0xffff0000u);
                    ov[e] = pk2(lo, hi); }
                *(u32x4*)(mix + (size_t)row * DM + c8 * 8) = ov;
            }
        }
    }
    SYNC(8);
    if (IN(9)) {
        PH_WS;
        pg8::Gemm g{mix, WoutT, T, DM, DM, DM, DM, 0, 0};
        if (G == 256) {
            pg8::PanelOrder S{bx};
            pg8::EpiResidNorm<true> E{x_in, outp, ada + 2 * DM, (const float*)a.in[I_N2G], (unsigned*)(ws + WS_ADAP + 1 * MiB), ctl + 16384 + 8192, (LAS float*)(lds + 131072), hbuf, ada};
            pg8::gemm_phase<pg8::EpiResidNorm<true>, pg8::PanelOrder>(lds, g, S, E, wave_s);
        } else {
            pg8::StaticOrder S; S.init(T, DM, G, bx);
            pg8::EpiResid E{x_in, outp, ada + 2 * DM};
            pg8::gemm_phase<pg8::EpiResid, pg8::StaticOrder>(lds, g, S, E, wave_s);
        }
    }
    SYNC(9);
    if (IN(10) && G != 256) { PH_IDS; norm_rows_mod(outp, hbuf, (const float*)a.in[I_N2G], ada + 4 * DM, ada + 3 * DM, gw, NGW, lane); }
    if (G != 256) SYNC(10);
    REPS(11) if (IN(11)) {
        PH_WS;
        pg8::Gemm g{hbuf, WguT, T, 2 * FF, DM, DM, DM, 0, 0}; pg8::StaticOrder S; S.init(T, 2 * FF, G, bx);
        pg8::EpiSwiglu E{hid};
        pg8::gemm_phase<pg8::EpiSwiglu, pg8::StaticOrder>(lds, g, S, E, wave_s);
    }
    SYNC(11);
    if (IN(12)) {
        PH_WS;
        pg8::Gemm g{hid, WdownT, T, DM, FF, FF, FF, 0, 0};
        if (G == 256) {
            pg8::PanelOrder S{bx};
            pg8::EpiResidNorm<false> E{outp, outp, ada + 5 * DM, (const float*)a.in[I_NFG], (unsigned*)(ws + WS_ADAP), ctl + 16384, (LAS float*)(lds + 131072), nullptr, ada};
            pg8::gemm_phase<pg8::EpiResidNorm<false>, pg8::PanelOrder>(lds, g, S, E, wave_s);
        } else {
            pg8::StaticOrder S; S.init(T, DM, G, bx);
            pg8::EpiResid E{outp, outp, ada + 5 * DM};
            pg8::gemm_phase<pg8::EpiResid, pg8::StaticOrder>(lds, g, S, E, wave_s);
        }
    }
    if (G != 256) SYNC(12);
    if (IN(13) && G != 256) {
        PH_IDS;
        const float* gf = (const float*)a.in[I_NFG];
        for (int row = gw; row < T; row += NGW) {
            f32x4* xr = (f32x4*)(outp + (size_t)row * DM) + lane;
            f32x4 v[8]; float ss = 0.f;
#pragma unroll
            for (int j = 0; j < 8; ++j) { v[j] = xr[64 * j]; ss += (v[j].x * v[j].x + v[j].y * v[j].y) + (v[j].z * v[j].z + v[j].w * v[j].w); }
            const float rstd = 1.0f / sqrtf(wave_sum(ss) * (1.0f / DM) + 1e-6f);
#pragma unroll
            for (int j = 0; j < 8; ++j) { const f32x4 g4 = *(const f32x4*)(gf + 4 * lane + 256 * j); xr[64 * j] = (v[j] * rstd) * g4; }
        }
    }
#undef IN
#undef SYNC
}

#ifndef MK_PER_PHASE
#define MK_PER_PHASE 0
#endif
constexpr int N_PHASES = 14;
extern "C" void kernel_launch(void* const* d_in, const int* in_sizes, int n_in, void* d_out, int out_size, void* d_ws, size_t ws_size, hipStream_t stream) {
    static int grid = 0;
    if (grid == 0) {
        if (n_in != 24 || in_sizes[0] != T * DM || out_size != T * DM || ws_size < WS_END) { fprintf(stderr, "kernel_launch: unexpected shapes: n_in %d in0 %d out %d ws %zu (need %zu)\n", n_in, n_in > 0 ? in_sizes[0] : -1, out_size, ws_size, (size_t)WS_END); grid = -1; return; }
        int dev = 0, cus = 0, per_cu = 0;
        if (hipGetDevice(&dev) != hipSuccess || hipDeviceGetAttribute(&cus, hipDeviceAttributeMultiprocessorCount, dev) != hipSuccess) { fprintf(stderr, "kernel_launch: device query failed\n"); grid = -1; return; }
        if (hipFuncSetAttribute((const void*)mk_fwd, hipFuncAttributeMaxDynamicSharedMemorySize, LDS_BYTES) != hipSuccess) { fprintf(stderr, "kernel_launch: hipFuncSetAttribute failed\n"); grid = -1; return; }
        if (hipOccupancyMaxActiveBlocksPerMultiprocessor(&per_cu, (const void*)mk_fwd, 512, LDS_BYTES) != hipSuccess || per_cu < 1) { fprintf(stderr, "kernel_launch: occupancy query says %d\n", per_cu); per_cu = 1; }
        (void)hipGetLastError();
        grid = cus * per_cu;
    }
    if (grid < 0) return;
    if (hipMemsetAsync((char*)d_ws + WS_CTL, 0, 1 * MiB, stream) != hipSuccess) { fprintf(stderr, "kernel_launch: memset failed\n"); return; }
    Args a{};
    for (int i = 0; i < 24; ++i) a.in[i] = d_in[i];
    a.out = (float*)d_out; a.ws = (unsigned char*)d_ws;
#if MK_PER_PHASE
    for (int ph = 0; ph < N_PHASES; ++ph) {
        a.ph_lo = ph; a.ph_hi = ph + 1;
        hipLaunchKernelGGL(mk_fwd, dim3(grid), dim3(512), LDS_BYTES, stream, a);
    }
#else
    a.ph_lo = 0; a.ph_hi = N_PHASES;
    void* args[] = {&a};
    hipError_t e = hipLaunchCooperativeKernel((const void*)mk_fwd, dim3(grid), dim3(512), args, LDS_BYTES, stream);
    if (e != hipSuccess) fprintf(stderr, "kernel_launch: cooperative launch failed: %s (grid %d)\n", hipGetErrorString(e), grid);
#endif
}
```

```cpp
#include <hip/hip_runtime.h>
#include <hip/hip_cooperative_groups.h>
#include <cstdio>
#include <cstdint>
namespace cg = cooperative_groups;

#define LAS __attribute__((address_space(3)))
typedef unsigned short bf16_t;
typedef short bf16x8 __attribute__((ext_vector_type(8)));
typedef short s16x4 __attribute__((ext_vector_type(4)));
typedef float f32x4 __attribute__((ext_vector_type(4)));
typedef float f32x2 __attribute__((ext_vector_type(2)));
typedef unsigned u32x4 __attribute__((ext_vector_type(4)));
typedef unsigned u32x2 __attribute__((ext_vector_type(2)));

constexpr int BATCH = 2, SEQ = 16384, DM = 2048, T = BATCH * SEQ;
constexpr int NPROJ = 6432, LDP = 6656;
constexpr int FF = 5632;
constexpr int ADA_N = 6 * DM;
constexpr int CL = 256, NCH = SEQ / CL;
constexpr int NCHAIN = BATCH * 16;
constexpr int PC_Q = 0, PC_K = 1024, PC_V = 2048, PC_R = 3072, PC_RK = 4096, PC_RV = 5120, PC_WL = 6144, PC_AL = 6208, PC_GL = 6272;

constexpr size_t MiB = 1u << 20;
constexpr size_t WS_CTL = 0;
constexpr size_t WS_ADAP = 1 * MiB;
constexpr size_t WS_ADA = 14 * MiB;
constexpr size_t WS_ROPE = 15 * MiB;
constexpr size_t WS_KKN = 17 * MiB;
constexpr size_t WS_LSE = 19 * MiB;
constexpr size_t WS_WLORA = 25 * MiB;
constexpr size_t WS_WIN = 27 * MiB;
constexpr size_t WS_WOUT = 53 * MiB;
constexpr size_t WS_WGU = 61 * MiB;
constexpr size_t WS_WDOWN = 105 * MiB;
constexpr size_t WS_LACT = 127 * MiB;
constexpr size_t WS_CS = 175 * MiB;
constexpr size_t WS_SINIT = 239 * MiB;
constexpr size_t WS_PROJ = 271 * MiB;
constexpr size_t WS_HBUF = 687 * MiB;
constexpr size_t WS_MIX = 815 * MiB;
constexpr size_t WS_OP2 = 943 * MiB;
constexpr size_t WS_END = 1007 * MiB;

constexpr int LDS_BYTES = 147456;

__device__ __forceinline__ float bf2f(bf16_t v) { return __uint_as_float((unsigned)v << 16); }
__device__ __forceinline__ unsigned f2bf(float f) { unsigned u = __float_as_uint(f); return (u + 0x7fffu + ((u >> 16) & 1u)) >> 16; }
__device__ __forceinline__ unsigned pk2(float lo, float hi) { return f2bf(lo) | (f2bf(hi) << 16); }
__device__ __forceinline__ unsigned pk2hw(float lo, float hi) { unsigned r; asm volatile("v_cvt_pk_bf16_f32 %0, %1, %2" : "=v"(r) : "v"(lo), "v"(hi)); return r; }
__device__ __forceinline__ float wave_sum(float v) {
#pragma unroll
    for (int o = 1; o < 64; o <<= 1) v += __shfl_xor(v, o);
    return v;
}
__device__ __forceinline__ float sigmoidf_(float x) { return 1.0f / (1.0f + __expf(-x)); }
#define LDS_WAIT() asm volatile("s_waitcnt lgkmcnt(0)" ::: "memory")
__device__ __forceinline__ int opaque_tid(int wave_s) { int t = (wave_s << 6) | (int)__builtin_amdgcn_mbcnt_hi(~0u, __builtin_amdgcn_mbcnt_lo(~0u, 0u)); asm volatile("" : "+v"(t)); return t; }

template <int CTRL> __device__ __forceinline__ float dpp_mov(float v) { return __int_as_float(__builtin_amdgcn_update_dpp(0, __float_as_int(v), CTRL, 0xF, 0xF, true)); }
__device__ __forceinline__ float wave_sum_dpp(float v) {
    v += dpp_mov<0xB1>(v); v += dpp_mov<0x4E>(v); v += dpp_mov<0x141>(v); v += dpp_mov<0x140>(v);
    const int vi = __float_as_int(v);
    return (__int_as_float(__builtin_amdgcn_readlane(vi, 0)) + __int_as_float(__builtin_amdgcn_readlane(vi, 16))) + (__int_as_float(__builtin_amdgcn_readlane(vi, 32)) + __int_as_float(__builtin_amdgcn_readlane(vi, 48)));
}

#define XB_TMO      128
#define XB_XCNT(j)  (256  + 64 * (j))
#define XB_XSUB(j)  (1280 + 64 * (j))
#define XB_XGEN(j)  (2304 + 64 * (j))
#define XB_TOP      3328
#define XB_TOPGEN   3392
#define XCD_BAR_WORDS 3456
#define XB_SPIN_CAP (1u << 22)
__device__ __forceinline__ unsigned xb_ld(unsigned* p)              { return __hip_atomic_load(p, __ATOMIC_RELAXED, __HIP_MEMORY_SCOPE_AGENT); }
__device__ __forceinline__ unsigned xb_add(unsigned* p, unsigned v) { return __hip_atomic_fetch_add(p, v, __ATOMIC_RELAXED, __HIP_MEMORY_SCOPE_AGENT); }
__device__ __forceinline__ unsigned xb_xcc_id() { return (unsigned)__builtin_amdgcn_s_getreg((3 << 11) | 20) & 0xFu; }
#define XB_SPIN(cond, bar) do { unsigned _sp = 0; while (cond) { __builtin_amdgcn_s_sleep(1); \
    if ((++_sp & 255u) == 0u) { if (xb_ld(&(bar)[XB_TMO])) break; if (_sp > XB_SPIN_CAP) { atomicAdd(&(bar)[XB_TMO], 1u); break; } } } } while (0)
struct XcdBarrier { unsigned* bar; unsigned x; volatile LAS unsigned* st; };
__device__ __forceinline__ XcdBarrier xcd_barrier_post(unsigned* bar, volatile LAS unsigned* st, bool leader) {
    XcdBarrier b; b.bar = bar; b.x = xb_xcc_id(); b.st = st;
    if (leader) (void)xb_add(&bar[XB_XCNT(b.x)], 1u);
    return b;
}
__device__ __forceinline__ void xcd_barrier_complete(unsigned* bar, unsigned x, unsigned& nloc, unsigned& nx) {
    const unsigned G = gridDim.x * gridDim.y * gridDim.z;
    unsigned sum, cnt, mine, sp = 0u;
    for (;;) {
        sum = 0u; cnt = 0u; mine = 0u;
#pragma unroll
        for (unsigned j = 0; j < 16; ++j) { const unsigned c = xb_ld(&bar[XB_XCNT(j)]); sum += c; cnt += (c > 0u) ? 1u : 0u; mine = (j == x) ? c : mine; }
        if (sum == G) break;
        __builtin_amdgcn_s_sleep(1);
        if ((++sp & 255u) == 0u) { if (xb_ld(&bar[XB_TMO])) break; if (sp > XB_SPIN_CAP) { atomicAdd(&bar[XB_TMO], 1u); break; } }
    }
    nloc = mine > 0u ? mine : 1u; nx = cnt > 0u ? cnt : 1u;
}
__device__ __forceinline__ void xcd_barrier(const XcdBarrier& b, int wave_s) {
    asm volatile("s_waitcnt vmcnt(0)" ::: "memory");
    __syncthreads();
    if (opaque_tid(wave_s) == 0) {
        unsigned* bar = b.bar;
        __builtin_amdgcn_s_waitcnt(0);
        unsigned nloc = b.st[0], nx = b.st[1];
        if (nloc == 0u) { xcd_barrier_complete(bar, b.x, nloc, nx); b.st[0] = nloc; b.st[1] = nx; }
        const unsigned old = xb_add(&bar[XB_XSUB(b.x)], 1u);
        const unsigned gen = old / nloc;
        if (old + 1u == (gen + 1u) * nloc) {
            __builtin_amdgcn_fence(__ATOMIC_RELEASE, "agent");
            asm volatile("s_waitcnt vmcnt(0)" ::: "memory");
            const unsigned og = xb_add(&bar[XB_TOP], 1u);
            const unsigned tg = og / nx;
            if (og + 1u == (tg + 1u) * nx) xb_add(&bar[XB_TOPGEN], 1u);
            else XB_SPIN(xb_ld(&bar[XB_TOPGEN]) == tg, bar);
            __builtin_amdgcn_fence(__ATOMIC_ACQUIRE, "agent");
            xb_add(&bar[XB_XGEN(b.x)], 1u);
            asm volatile("s_waitcnt vmcnt(0)" ::: "memory");
        } else {
            XB_SPIN(xb_ld(&bar[XB_XGEN(b.x)]) == gen, bar);
            __builtin_amdgcn_fence(__ATOMIC_ACQUIRE, "agent");
            asm volatile("s_waitcnt vmcnt(0)" ::: "memory");
        }
    }
    __syncthreads();
}

namespace pg8 {
#define PG8_LAS __attribute__((address_space(3)))
constexpr int BM = 256, BK = 64, HALF = 128, HTB = HALF * BK * 2, STAGE_BYTES = 8 * HTB, NXCD = 8, WGM = 8;

__host__ __device__ __forceinline__ int lds_byte(int r, int c) { const int st = (r >> 4) * 2 + (c >> 5), rr = r & 15, cc = c & 31, ob = rr * 64 + cc * 2; return st * 1024 + (ob ^ (((ob >> 9) & 1) << 5)); }
__host__ __device__ __forceinline__ void stage_rc(int b, int& R, int& C) { const int st = b / 1024, sb = b % 1024, swz = sb ^ (((sb >> 9) & 1) << 5); R = (st >> 1) * 16 + swz / 64; C = (st & 1) * 32 + (swz % 64) / 2; }
__host__ __device__ __forceinline__ int perm32(int rho) { const int n = rho >> 4, i = rho & 15; return 8 * (i >> 2) + 4 * n + (i & 3); }

struct Unit { int pm, pn; };
struct Gemm { const bf16_t* A; const bf16_t* Bt; int M, N, K, lda, ldb, agrp, kshort; };

struct StaticOrder {
    int nM, nN, nwg, G, c;
    __host__ __device__ void init(int M, int N, int G_, int c_) { nM = M / BM; nN = N / BM; nwg = nM * nN; G = G_; c = c_; }
    __host__ __device__ bool next(int i, Unit& u) const {
        const long L = (long)i * G + c; if (L >= nwg) return false;
        int wgid = (int)L; { const int q = nwg / NXCD, r = nwg % NXCD, xcd = wgid % NXCD, off = wgid / NXCD; wgid = (xcd < r ? xcd * (q + 1) : r * (q + 1) + (xcd - r) * q) + off; }
        const int nig = WGM * nN, gid = wgid / nig, fm = gid * WGM, gsz = (nM - fm) < WGM ? (nM - fm) : WGM;
        u.pm = fm + ((wgid % nig) % gsz); u.pn = (wgid % nig) / gsz; return true;
    }
};

__device__ __forceinline__ unsigned cvt_pk_bf16(float lo, float hi) { unsigned r; asm volatile("v_cvt_pk_bf16_f32 %0, %1, %2" : "=v"(r) : "v"(lo), "v"(hi)); return r; }


struct EpiProj {
    static constexpr bool PERM = true;
    bf16_t* O; int ldc; const float* rope;
    __device__ __forceinline__ void operator()(f32x4 (&acc)[2][2][4][2], const Unit& u, int wr, int wc, int fr, int fq) const {
        const int row0 = u.pm * BM + wr * 64 + fr;
        const float sc = (u.pn < 4) ? 0.125f : 1.0f;
        if (u.pn < 8 && (wc & 1) == 0) {
            const float sg = (fq == 0) ? -1.0f : 1.0f;
            const bool act = fq < 2;
#pragma unroll
            for (int ai = 0; ai < 2; ++ai)
#pragma unroll
                for (int m = 0; m < 4; ++m) {
                    const int row = row0 + ai * HALF + m * 16;
                    const f32x4* rp = (const f32x4*)(rope + (size_t)row * 16);
                    const f32x4 cz[2] = {rp[0], rp[1]}, sz[2] = {rp[2], rp[3]};
#pragma unroll
                    for (int bj = 0; bj < 2; ++bj)
#pragma unroll
                        for (int n = 0; n < 2; ++n) {
                            f32x4 x = acc[ai][bj][m][n], p;
#pragma unroll
                            for (int j = 0; j < 4; ++j) p[j] = __shfl_xor(x[j], 16);
                            const f32x4 y = x * cz[n] + (p * sz[n]) * sg;
                            acc[ai][bj][m][n] = act ? y : x;
                        }
                }
        }
        const int col0 = u.pn * BM + wc * 32 + 8 * fq;
#pragma unroll
        for (int ai = 0; ai < 2; ++ai)
#pragma unroll
            for (int m = 0; m < 4; ++m) { bf16_t* rowp = O + (size_t)(row0 + ai * HALF + m * 16) * ldc + col0;
#pragma unroll
                for (int bj = 0; bj < 2; ++bj) { const f32x4 v0 = acc[ai][bj][m][0] * sc, v1 = acc[ai][bj][m][1] * sc;
                    u32x4 w; w.x = cvt_pk_bf16(v0[0], v0[1]); w.y = cvt_pk_bf16(v0[2], v0[3]); w.z = cvt_pk_bf16(v1[0], v1[1]); w.w = cvt_pk_bf16(v1[2], v1[3]);
                    *(u32x4*)(rowp + bj * HALF) = w; } }
    }
};

typedef _Float16 f16x2 __attribute__((ext_vector_type(2)));
__device__ __forceinline__ unsigned pk_f16(float lo, float hi) { f16x2 h; h.x = (_Float16)lo; h.y = (_Float16)hi; return __builtin_bit_cast(unsigned, h); }
struct EpiLora {
    static constexpr bool PERM = true;
    _Float16* O; const float* bias;
    __device__ __forceinline__ void operator()(f32x4 (&acc)[2][2][4][2], const Unit& u, int wr, int wc, int fr, int fq) const {
        const int row0 = u.pm * BM + wr * 64 + fr, col0 = u.pn * BM + wc * 32 + 8 * fq;
        const int grp = u.pn >> 2; const float alpha = (grp == 0) ? 0.60653066f : (grp == 1) ? 1.0f : 0.0f, beta = (grp == 2) ? 1.0f : 0.0f;
        f32x4 bv[2][2];
#pragma unroll
        for (int bj = 0; bj < 2; ++bj)
#pragma unroll
            for (int n = 0; n < 2; ++n) bv[bj][n] = *(const f32x4*)(bias + col0 + bj * HALF + 4 * n);
#pragma unroll
        for (int ai = 0; ai < 2; ++ai)
#pragma unroll
            for (int m = 0; m < 4; ++m) { _Float16* rowp = O + (size_t)(row0 + ai * HALF + m * 16) * 3072 + col0;
#pragma unroll
                for (int bj = 0; bj < 2; ++bj) { f32x4 v0 = acc[ai][bj][m][0] + bv[bj][0], v1 = acc[ai][bj][m][1] + bv[bj][1];
#pragma unroll
                    for (int j = 0; j < 4; ++j) { v0[j] = alpha * __builtin_amdgcn_rcpf(1.0f + __expf(-v0[j])) + beta * v0[j]; v1[j] = alpha * __builtin_amdgcn_rcpf(1.0f + __expf(-v1[j])) + beta * v1[j]; }
                    u32x4 w; w.x = pk_f16(v0[0], v0[1]); w.y = pk_f16(v0[2], v0[3]); w.z = pk_f16(v1[0], v1[1]); w.w = pk_f16(v1[2], v1[3]);
                    *(u32x4*)(rowp + bj * HALF) = w; } }
    }
};

struct EpiResid {
    static constexpr bool PERM = false;
    const float* base; float* out; const float* gate;
    __device__ __forceinline__ void operator()(f32x4 (&acc)[2][2][4][2], const Unit& u, int wr, int wc, int fr, int fq) const {
        const int row0 = u.pm * BM + wr * 64 + fr, col0 = u.pn * BM + wc * 32 + 4 * fq;
        const float* gp = gate + ((u.pm * BM) >= SEQ ? ADA_N : 0) + col0;
        f32x4 gv[2][2];
#pragma unroll
        for (int bj = 0; bj < 2; ++bj)
#pragma unroll
            for (int n = 0; n < 2; ++n) gv[bj][n] = *(const f32x4*)(gp + bj * HALF + n * 16);
#pragma unroll
        for (int ai = 0; ai < 2; ++ai)
#pragma unroll
            for (int m = 0; m < 4; ++m) { const size_t off = (size_t)(row0 + ai * HALF + m * 16) * DM + col0;
#pragma unroll
                for (int bj = 0; bj < 2; ++bj)
#pragma unroll
                    for (int n = 0; n < 2; ++n) { const f32x4 bs = *(const f32x4*)(base + off + bj * HALF + n * 16);
                        *(f32x4*)(out + off + bj * HALF + n * 16) = bs + gv[bj][n] * acc[ai][bj][m][n]; } }
    }
};

struct PanelOrder {
    int c;
    __device__ __forceinline__ bool next(int i, Unit& u) const { if (i >= 4) return false; const int x = c & 7, l = c >> 3; u.pm = x * 16 + i * 4 + (l >> 3); u.pn = l & 7; return true; }
};
template <bool MID> struct EpiResidNorm {
    static constexpr bool PERM = false;
    const float* base; float* out; const float* gate; const float* gf; unsigned* xbuf; unsigned* cnt; PG8_LAS float* ls;
    bf16_t* hb; const float* adab;
    __device__ __forceinline__ void operator()(f32x4 (&acc)[2][2][4][2], const Unit& u, int wr, int wc, int fr, int fq) const {
        const int rl0 = wr * 64 + fr, col0 = u.pn * BM + wc * 32 + 4 * fq, tid = (wr * 4 + wc) * 64 + fq * 16 + fr;
        PG8_LAS float* P = ls; PG8_LAS float* S = ls + 1024;
        const float* gp = gate + ((u.pm * BM) >= SEQ ? ADA_N : 0) + col0;
        f32x4 gv[2][2];
#pragma unroll
        for (int bj = 0; bj < 2; ++bj)
#pragma unroll
            for (int n = 0; n < 2; ++n) gv[bj][n] = *(const f32x4*)(gp + bj * HALF + n * 16);
#pragma unroll
        for (int ai = 0; ai < 2; ++ai)
#pragma unroll
            for (int m = 0; m < 4; ++m) { const int rl = rl0 + ai * HALF + m * 16; const size_t off = (size_t)(u.pm * BM + rl) * DM + col0; float ss = 0.f;
#pragma unroll
                for (int bj = 0; bj < 2; ++bj)
#pragma unroll
                    for (int n = 0; n < 2; ++n) { const f32x4 bs = *(const f32x4*)(base + off + bj * HALF + n * 16); const f32x4 o = bs + gv[bj][n] * acc[ai][bj][m][n];
                        acc[ai][bj][m][n] = o; ss += (o.x * o.x + o.y * o.y) + (o.z * o.z + o.w * o.w); }
                ss += __shfl_xor(ss, 16); ss += __shfl_xor(ss, 32);
                if (fq == 0) P[rl * 4 + wc] = ss; }
        asm volatile("s_waitcnt lgkmcnt(0)" ::: "memory"); __builtin_amdgcn_s_barrier(); asm volatile("" ::: "memory");
        if (tid < 256) { const f32x4 p4 = *(const PG8_LAS f32x4*)(P + tid * 4);
            __hip_atomic_store(xbuf + (size_t)(u.pm * 8 + u.pn) * 256 + tid, __float_as_uint((p4.x + p4.y) + (p4.z + p4.w)), __ATOMIC_RELAXED, __HIP_MEMORY_SCOPE_AGENT); }
        asm volatile("s_waitcnt vmcnt(0)" ::: "memory"); __builtin_amdgcn_s_barrier(); asm volatile("" ::: "memory");
        if (tid == 0) {
            __builtin_amdgcn_fence(__ATOMIC_RELEASE, "agent"); asm volatile("s_waitcnt vmcnt(0)" ::: "memory");
            __hip_atomic_fetch_add(cnt + 64 * u.pm, 1u, __ATOMIC_RELAXED, __HIP_MEMORY_SCOPE_AGENT);
            unsigned sp = 0;
            while (__hip_atomic_load(cnt + 64 * u.pm, __ATOMIC_RELAXED, __HIP_MEMORY_SCOPE_AGENT) < 8u) { __builtin_amdgcn_s_sleep(2); if (++sp > (1u << 22)) break; }
            __builtin_amdgcn_fence(__ATOMIC_ACQUIRE, "agent"); asm volatile("s_waitcnt vmcnt(0)" ::: "memory");
        }
        asm volatile("s_waitcnt lgkmcnt(0)" ::: "memory"); __builtin_amdgcn_s_barrier(); asm volatile("" ::: "memory");
        if (tid < 256) { float sq = 0.f;
#pragma unroll
            for (int t = 0; t < 8; ++t) sq += __uint_as_float(__hip_atomic_load(xbuf + (size_t)(u.pm * 8 + t) * 256 + tid, __ATOMIC_RELAXED, __HIP_MEMORY_SCOPE_AGENT));
            S[tid] = __builtin_amdgcn_rsqf(sq * (1.0f / DM) + 1e-6f); }
        asm volatile("s_waitcnt lgkmcnt(0)" ::: "memory"); __builtin_amdgcn_s_barrier(); asm volatile("" ::: "memory");
        f32x4 fv[2][2], sv[2][2];
        const float* ab = adab + ((u.pm * BM) >= SEQ ? ADA_N : 0) + col0;
#pragma unroll
        for (int bj = 0; bj < 2; ++bj)
#pragma unroll
            for (int n = 0; n < 2; ++n) { fv[bj][n] = *(const f32x4*)(gf + col0 + bj * HALF + n * 16);
                if (MID) { fv[bj][n] = fv[bj][n] * (*(const f32x4*)(ab + 4 * DM + bj * HALF + n * 16) + 1.0f); sv[bj][n] = *(const f32x4*)(ab + 3 * DM + bj * HALF + n * 16); } }
#pragma unroll
        for (int ai = 0; ai < 2; ++ai)
#pragma unroll
            for (int m = 0; m < 4; ++m) { const int rl = rl0 + ai * HALF + m * 16; const size_t off = (size_t)(u.pm * BM + rl) * DM + col0; const float rs = S[rl];
#pragma unroll
                for (int bj = 0; bj < 2; ++bj)
#pragma unroll
                    for (int n = 0; n < 2; ++n) {
                        if (MID) { const f32x4 o = acc[ai][bj][m][n]; *(f32x4*)(out + off + bj * HALF + n * 16) = o;
                            const f32x4 y = (o * rs) * fv[bj][n] + sv[bj][n]; u32x2 w; w.x = cvt_pk_bf16(y.x, y.y); w.y = cvt_pk_bf16(y.z, y.w); *(u32x2*)(hb + off + bj * HALF + n * 16) = w; }
                        else *(f32x4*)(out + off + bj * HALF + n * 16) = (acc[ai][bj][m][n] * rs) * fv[bj][n]; } }
    }
};

struct EpiSwiglu {
    static constexpr bool PERM = true;
    bf16_t* O;
    __device__ __forceinline__ void operator()(f32x4 (&acc)[2][2][4][2], const Unit& u, int wr, int wc, int fr, int fq) const {
        const int row0 = u.pm * BM + wr * 64 + fr, col0 = u.pn * HALF + wc * 32 + 8 * fq;
#pragma unroll
        for (int ai = 0; ai < 2; ++ai)
#pragma unroll
            for (int m = 0; m < 4; ++m) {
                f32x4 h[2];
#pragma unroll
                for (int n = 0; n < 2; ++n) { const f32x4 gte = acc[ai][0][m][n], up = acc[ai][1][m][n];
#pragma unroll
                    for (int j = 0; j < 4; ++j) h[n][j] = gte[j] * __builtin_amdgcn_rcpf(1.0f + __expf(-gte[j])) * up[j]; }
                u32x4 w; w.x = cvt_pk_bf16(h[0][0], h[0][1]); w.y = cvt_pk_bf16(h[0][2], h[0][3]); w.z = cvt_pk_bf16(h[1][0], h[1][1]); w.w = cvt_pk_bf16(h[1][2], h[1][3]);
                *(u32x4*)(O + (size_t)(row0 + ai * HALF + m * 16) * FF + col0) = w;
            }
    }
};

template <class Epi, class Sched>
__device__ __forceinline__ void gemm_phase(PG8_LAS unsigned char* lds, const Gemm g, const Sched& S, const Epi& E, int wave_s) {
    const int tid = opaque_tid(wave_s), wid = __builtin_amdgcn_readfirstlane(tid >> 6), lane = tid & 63, wr = wid >> 2, wc = wid & 3, fr = lane & 15, fq = lane >> 4;
    const int K = g.K;
#define PG8_NT(un) ((g.kshort > 0 && ((un).pn >> 2) < 2) ? g.kshort / BK : K / BK)
    unsigned voffA[2], voffB[2];
#pragma unroll
    for (int i = 0; i < 2; ++i) { int R, C; stage_rc(tid * 16 + i * 8192, R, C); const int Rb = Epi::PERM ? ((R & ~31) + perm32(R & 31)) : R;
        voffA[i] = (unsigned)(R * g.lda + C) * 2u; voffB[i] = (unsigned)(Rb * g.ldb + C) * 2u; }
    const size_t kstep = (size_t)(BK * 2);
    const size_t hstepA = (size_t)HALF * g.lda * 2, hstepB = (size_t)HALF * g.ldb * 2;
    const size_t tstepA = 2 * hstepA, tstepB = 2 * hstepB;
    const unsigned ldsw = (unsigned)wid * 1024u;
    const int aoff = lds_byte(wr * 64 + fr, fq * 8), boff = lds_byte(wc * 32 + fr, fq * 8);
#define PG8_SA(b, h) (((b) * 2 + (h)) * HTB)
#define PG8_SB(b, h) ((4 + (b) * 2 + (h)) * HTB)
#define PG8_STAGE(bufoff, gbase, voff) do { _Pragma("unroll") for (int _i = 0; _i < 2; ++_i) \
        __builtin_amdgcn_global_load_lds((const unsigned*)((const char*)(gbase) + (voff)[_i]), (PG8_LAS unsigned*)(lds + (bufoff) + ldsw + _i * 8192), 16, 0, 0); } while (0)
#define PG8_LDA(dst, b, h) do { _Pragma("unroll") for (int m = 0; m < 4; ++m) _Pragma("unroll") for (int k = 0; k < 2; ++k) dst[m][k] = *(const PG8_LAS bf16x8*)(lds + PG8_SA(b, h) + aoff + m * 2048 + k * 1024); } while (0)
#define PG8_LDB(dst, b, h) do { _Pragma("unroll") for (int n = 0; n < 2; ++n) _Pragma("unroll") for (int k = 0; k < 2; ++k) dst[n][k] = *(const PG8_LAS bf16x8*)(lds + PG8_SB(b, h) + boff + n * 2048 + k * 1024); } while (0)
#define PG8_MMA(ai, bj, At, Bt) do { __builtin_amdgcn_s_setprio(1); _Pragma("unroll") for (int m = 0; m < 4; ++m) _Pragma("unroll") for (int n = 0; n < 2; ++n) _Pragma("unroll") for (int k = 0; k < 2; ++k) \
        acc[ai][bj][m][n] = __builtin_amdgcn_mfma_f32_16x16x32_bf16(Bt[n][k], At[m][k], acc[ai][bj][m][n], 0, 0, 0); __builtin_amdgcn_s_setprio(0); } while (0)
#define PG8_WAIT_V(n) asm volatile("s_waitcnt vmcnt(" #n ")" ::: "memory")
#define PG8_WAIT_L(n) asm volatile("s_waitcnt lgkmcnt(" #n ")" ::: "memory")
#define PG8_BAR __builtin_amdgcn_s_barrier()
#define PG8_SCHED __builtin_amdgcn_sched_barrier(0)
    Unit cur, nxt; int ui = 0;
    if (!S.next(0, cur)) return;
    int nt = PG8_NT(cur);
    f32x4 acc[2][2][4][2];
#pragma unroll
    for (int a = 0; a < 2; ++a)
#pragma unroll
        for (int b = 0; b < 2; ++b)
#pragma unroll
            for (int m = 0; m < 4; ++m)
#pragma unroll
                for (int n = 0; n < 2; ++n) acc[a][b][m][n] = (f32x4){0.f, 0.f, 0.f, 0.f};
    bf16x8 At[4][2], B0[2][2], B1[2][2];
    const char* cA = (const char*)g.A + (size_t)cur.pm * tstepA + (size_t)((cur.pn >> 2) * g.agrp) * 2; const char* cB = (const char*)g.Bt + (size_t)cur.pn * tstepB;
    PG8_STAGE(PG8_SB(0, 0), cB, voffB); PG8_STAGE(PG8_SB(0, 1), cB + hstepB, voffB); PG8_STAGE(PG8_SA(0, 0), cA, voffA); PG8_STAGE(PG8_SA(0, 1), cA + hstepA, voffA);
    if (wr == 1) PG8_BAR;
    PG8_WAIT_V(2); PG8_BAR;
    PG8_STAGE(PG8_SB(1, 0), cB + kstep, voffB); PG8_STAGE(PG8_SA(1, 0), cA + kstep, voffA); PG8_STAGE(PG8_SB(1, 1), cB + hstepB + kstep, voffB);
    PG8_WAIT_V(6); PG8_BAR;
    for (;;) {
        const bool has_next = S.next(ui + 1, nxt);
        const char* nA = has_next ? (const char*)g.A + (size_t)nxt.pm * tstepA + (size_t)((nxt.pn >> 2) * g.agrp) * 2 : cA; const char* nB = has_next ? (const char*)g.Bt + (size_t)nxt.pn * tstepB : cB;
        for (int t = 0; t < nt; t += 2) {
            const bool last = (t == nt - 2);
            const char* a1 = cA + (size_t)(t + 1) * kstep;
            const char* a2 = last ? nA : cA + (size_t)(t + 2) * kstep; const char* b2 = last ? nB : cB + (size_t)(t + 2) * kstep;
            const char* a3 = a2 + kstep; const char* b3 = b2 + kstep;
            PG8_LDB(B0, 0, 0); PG8_LDB(B1, 0, 1); PG8_SCHED; PG8_LDA(At, 0, 0); PG8_STAGE(PG8_SA(1, 1), a1 + hstepA, voffA);
            PG8_WAIT_V(8); PG8_WAIT_L(0); PG8_BAR; PG8_MMA(0, 0, At, B0); PG8_MMA(0, 1, At, B1); PG8_BAR; PG8_SCHED;
            PG8_LDA(At, 0, 1); PG8_STAGE(PG8_SB(0, 0), b2, voffB); PG8_STAGE(PG8_SB(0, 1), b2 + hstepB, voffB); PG8_STAGE(PG8_SA(0, 0), a2, voffA);
            PG8_WAIT_V(8); PG8_WAIT_L(0); PG8_BAR; PG8_MMA(1, 0, At, B0); PG8_MMA(1, 1, At, B1); PG8_BAR; PG8_SCHED;
            PG8_LDB(B0, 1, 0); PG8_LDB(B1, 1, 1); PG8_SCHED; PG8_LDA(At, 1, 0); PG8_STAGE(PG8_SA(0, 1), a2 + hstepA, voffA);
            PG8_WAIT_V(8); PG8_WAIT_L(0); PG8_BAR; PG8_MMA(0, 0, At, B0); PG8_MMA(0, 1, At, B1); PG8_BAR; PG8_SCHED;
            PG8_LDA(At, 1, 1); PG8_STAGE(PG8_SB(1, 0), b3, voffB); PG8_STAGE(PG8_SB(1, 1), b3 + hstepB, voffB); PG8_STAGE(PG8_SA(1, 0), a3, voffA);
            PG8_WAIT_V(8); PG8_WAIT_L(0); PG8_BAR; PG8_MMA(1, 0, At, B0); PG8_MMA(1, 1, At, B1); PG8_BAR; PG8_SCHED;
        }
        if (wr == 0) PG8_BAR;
        E(acc, cur, wr, wc, fr, fq);
        if (!has_next) break;
#pragma unroll
        for (int a = 0; a < 2; ++a)
#pragma unroll
            for (int b = 0; b < 2; ++b)
#pragma unroll
                for (int m = 0; m < 4; ++m)
#pragma unroll
                    for (int n = 0; n < 2; ++n) acc[a][b][m][n] = (f32x4){0.f, 0.f, 0.f, 0.f};
        cur = nxt; cA = nA; cB = nB; ++ui; nt = PG8_NT(cur);
        if (wr == 1) PG8_BAR;
    }
    PG8_WAIT_V(0);
    PG8_BAR;
#undef PG8_NT
#undef PG8_SA
#undef PG8_SB
#undef PG8_STAGE
#undef PG8_LDA
#undef PG8_LDB
#undef PG8_MMA
#undef PG8_WAIT_V
#undef PG8_WAIT_L
#undef PG8_BAR
#undef PG8_SCHED
}
}

struct Args { const void* in[24]; float* out; unsigned char* ws; int ph_lo, ph_hi; };
enum { I_X = 0, I_C, I_POS, I_WADA, I_BADA, I_N1G, I_N2G, I_NFG, I_WIN, I_WOUT, I_MU, I_W0, I_WDEC, I_A0, I_WICLR, I_WGATE, I_KK, I_KA, I_RK, I_GNG, I_GNB, I_FG, I_FU, I_FD };

__device__ __forceinline__ void transpose_item(const float* W, int Ksrc, int N, bf16_t* WT, int ldk, int drow0, int k0, int n0, LAS float* scr, int lane) {
    float tv[32];
#pragma unroll
    for (int i = 0; i < 32; ++i) { const int k = k0 + 2 * i + (lane >> 5); tv[i] = (k < Ksrc) ? W[(size_t)k * N + n0 + (lane & 31)] : 0.f; }
#pragma unroll
    for (int i = 0; i < 32; ++i) scr[(2 * i + (lane >> 5)) * 33 + (lane & 31)] = tv[i];
    LDS_WAIT();
    const int c = lane & 7;
#pragma unroll
    for (int j = 0; j < 4; ++j) { const int n = (lane >> 3) + 8 * j; const LAS float* s = scr + (8 * c) * 33 + n;
        u32x4 o; o.x = pk2(s[0 * 33], s[1 * 33]); o.y = pk2(s[2 * 33], s[3 * 33]); o.z = pk2(s[4 * 33], s[5 * 33]); o.w = pk2(s[6 * 33], s[7 * 33]);
        *(u32x4*)(WT + (size_t)(drow0 + n) * ldk + k0 + 8 * c) = o; }
    LDS_WAIT();
}

__device__ __forceinline__ void norm_rows_mod(const float* X, bf16_t* H, const float* gvec, const float* sc, const float* sh, int gw, int NGW, int lane) {
    for (int row = gw; row < T; row += NGW) {
        const int bo = (row >= SEQ) ? ADA_N : 0;
        const f32x4* xr = (const f32x4*)(X + (size_t)row * DM) + lane;
        f32x4 v[8]; float ss = 0.f;
#pragma unroll
        for (int j = 0; j < 8; ++j) { v[j] = xr[64 * j]; ss += (v[j].x * v[j].x + v[j].y * v[j].y) + (v[j].z * v[j].z + v[j].w * v[j].w); }
        const float rstd = 1.0f / sqrtf(wave_sum(ss) * (1.0f / DM) + 1e-6f);
        u32x2* o8 = (u32x2*)(H + (size_t)row * DM) + lane;
#pragma unroll
        for (int j = 0; j < 8; ++j) { const int col = 4 * lane + 256 * j;
            const f32x4 g4 = *(const f32x4*)(gvec + col), s4 = *(const f32x4*)(sc + bo + col), h4 = *(const f32x4*)(sh + bo + col);
            const f32x4 y = (v[j] * rstd) * g4 * (s4 + 1.0f) + h4;
            u32x2 w; w.x = pk2(y.x, y.y); w.y = pk2(y.z, y.w); o8[64 * j] = w; }
    }
}

struct ScanPtrs {
    const bf16_t* proj; const _Float16* lz; const float* kkn;
    const float *mu, *k_k, *k_a, *r_k, *gn_g, *gn_b;
    float* cs; float* sinit; bf16_t* mix;
};
template <int MODE, int TS>
__device__ __forceinline__ void scan_item(LAS float* W, const ScanPtrs& p, int chain, int c, int lane) {
    const int b = chain >> 4, h = chain & 15, hc = h * 64 + lane, rg = lane >> 2, cgi = lane & 3;
    f32x2 su[4][8];
    if (MODE == 2 && c > 0) {
#pragma unroll
        for (int r = 0; r < 4; ++r) { const f32x4* sp = (const f32x4*)(p.sinit + ((size_t)(chain * NCH + c) * 4096 + (4 * rg + r) * 64 + 16 * cgi));
#pragma unroll
            for (int i = 0; i < 4; ++i) { const f32x4 t = sp[i]; su[r][2 * i] = t.xy; su[r][2 * i + 1] = t.zw; } }
    } else {
#pragma unroll
        for (int r = 0; r < 4; ++r)
#pragma unroll
            for (int cc = 0; cc < 8; ++cc) su[r][cc] = (MODE == 1) ? (f32x2){(4 * rg + r == 16 * cgi + 2 * cc) ? 1.f : 0.f, (4 * rg + r == 16 * cgi + 2 * cc + 1) ? 1.f : 0.f} : (f32x2){0.f, 0.f};
    }
    const float mu_r = p.mu[hc], mu_k = p.mu[1024 + hc], mu_v = p.mu[2048 + hc], kkc = p.k_k[hc], kac = p.k_a[hc];
    float rkc = 0.f, gng = 0.f, gnb = 0.f;
    if (MODE == 2) { rkc = p.r_k[hc]; gng = p.gn_g[hc]; gnb = p.gn_b[hc]; }
    const int t0 = c * CL; const size_t row0 = (size_t)b * SEQ + t0;
    float rp = 0.f, kp = 0.f, vp = 0.f;
    if (t0 > 0) { const bf16_t* pr = p.proj + (row0 - 1) * LDP; rp = bf2f(pr[PC_R + hc]); kp = bf2f(pr[PC_RK + hc]); vp = bf2f(pr[PC_RV + hc]); }
    bf16_t qr[TS], qk[TS], qv[TS]; _Float16 qz[TS], qa[TS], qg[TS]; float qn[TS];
#define SCAN_LOAD(sc_) do { _Pragma("unroll") for (int st = 0; st < TS; ++st) { const size_t row = row0 + (sc_) * TS + st; const bf16_t* pr = p.proj + row * LDP; const _Float16* lzr = p.lz + row * 3072 + hc; \
        if (MODE != 1) { qr[st] = pr[PC_R + hc]; qv[st] = pr[PC_RV + hc]; } qk[st] = pr[PC_RK + hc]; qz[st] = lzr[0]; qa[st] = lzr[1024]; if (MODE == 2) qg[st] = lzr[2048]; qn[st] = p.kkn[row * 16 + h]; } } while (0)
    SCAN_LOAD(0);
#pragma unroll 1
    for (int sc = 0; sc < CL / TS; ++sc) {
#pragma unroll
        for (int st = 0; st < TS; ++st) {
            const float kc = bf2f(qk[st]);
            const float k = kc + (kp - kc) * mu_k; kp = kc;
            const float av = (float)qa[st], inv = qn[st];
            const float dec = __expf(-(float)qz[st]);
            const float kk = k * kkc * inv;
            LAS float* V = W + st * 512;
            V[lane] = -kk; V[64 + lane] = dec; V[128 + lane] = kk * av;
            if (MODE != 1) {
                const float rc = bf2f(qr[st]), vc = bf2f(qv[st]);
                const float r = rc + (rp - rc) * mu_r, v = vc + (vp - vc) * mu_v; rp = rc; vp = vc;
                const float kpr = k * (1.0f + (av - 1.0f) * kac);
                V[192 + lane] = kpr; V[320 + lane] = v;
                if (MODE == 2) { V[256 + lane] = r; V[384 + lane] = (float)qg[st]; }
            }
        }
        if (sc + 1 < CL / TS) SCAN_LOAD(sc + 1);
#pragma unroll 4
        for (int st = 0; st < TS; ++st) {
            const LAS float* V = W + st * 512;
            const LAS f32x4* Nq = (const LAS f32x4*)(V + 16 * cgi);
            const LAS f32x4* Dq = (const LAS f32x4*)(V + 64 + 16 * cgi); const LAS f32x4* Bq = (const LAS f32x4*)(V + 128 + 16 * cgi); const LAS f32x4* Kq = (const LAS f32x4*)(V + 192 + 16 * cgi);
            const LAS f32x4* Rq = (const LAS f32x4*)(V + 256 + 16 * cgi);
            f32x4 n4[4], d4[4], b4[4], k4[4], r4[4], v4 = {0.f, 0.f, 0.f, 0.f};
#pragma unroll
            for (int i = 0; i < 4; ++i) n4[i] = Nq[i];
#pragma unroll
            for (int i = 0; i < 4; ++i) { d4[i] = Dq[i]; b4[i] = Bq[i]; if (MODE != 1) k4[i] = Kq[i]; if (MODE == 2) r4[i] = Rq[i]; }
            if (MODE != 1) v4 = *(const LAS f32x4*)(V + 320 + 4 * rg);
            f32x2 au[4];
#pragma unroll
            for (int r = 0; r < 4; ++r) au[r] = (f32x2){0.f, 0.f};
#pragma unroll
            for (int i = 0; i < 4; ++i)
#pragma unroll
                for (int r = 0; r < 4; ++r) { au[r] += su[r][2 * i] * n4[i].xy; au[r] += su[r][2 * i + 1] * n4[i].zw; }
            float sau[4];
#pragma unroll
            for (int r = 0; r < 4; ++r) { float t = au[r].x + au[r].y; t += dpp_mov<0xB1>(t); t += dpp_mov<0x4E>(t); sau[r] = t; }
            f32x2 ao[4];
#pragma unroll
            for (int r = 0; r < 4; ++r) ao[r] = (f32x2){0.f, 0.f};
#pragma unroll
            for (int i = 0; i < 4; ++i) {
#pragma unroll
                for (int r = 0; r < 4; ++r) {
                    if (MODE == 1) { su[r][2 * i] = su[r][2 * i] * d4[i].xy + b4[i].xy * sau[r]; su[r][2 * i + 1] = su[r][2 * i + 1] * d4[i].zw + b4[i].zw * sau[r]; }
                    else { su[r][2 * i] = su[r][2 * i] * d4[i].xy + b4[i].xy * sau[r] + k4[i].xy * v4[r]; su[r][2 * i + 1] = su[r][2 * i + 1] * d4[i].zw + b4[i].zw * sau[r] + k4[i].zw * v4[r]; }
                    if (MODE == 2) { ao[r] += su[r][2 * i] * r4[i].xy; ao[r] += su[r][2 * i + 1] * r4[i].zw; }
                }
            }
            if (MODE == 2) {
                float o[4];
#pragma unroll
                for (int r = 0; r < 4; ++r) { float t = ao[r].x + ao[r].y; t += dpp_mov<0xB1>(t); t += dpp_mov<0x4E>(t); o[r] = t; }
                const float osel = (cgi == 0) ? o[0] : (cgi == 1) ? o[1] : (cgi == 2) ? o[2] : o[3];
                W[st * 512 + 128 + lane] = osel;
            }
        }
        if (MODE == 2) {
            const int pst = lane >> 3, pc = (lane & 7) * 8;
            const LAS float* V = W + pst * 512;
            const f32x4 x0 = *(const LAS f32x4*)(V + 128 + pc), x1 = *(const LAS f32x4*)(V + 128 + pc + 4);
            float sm = ((x0.x + x0.y) + (x0.z + x0.w)) + ((x1.x + x1.y) + (x1.z + x1.w));
            sm += dpp_mov<0xB1>(sm); sm += dpp_mov<0x4E>(sm); sm += dpp_mov<0x141>(sm);
            const float mean = sm * (1.0f / 64.0f);
            const f32x4 d0 = x0 - mean, d1 = x1 - mean;
            float sq = ((d0.x * d0.x + d0.y * d0.y) + (d0.z * d0.z + d0.w * d0.w)) + ((d1.x * d1.x + d1.y * d1.y) + (d1.z * d1.z + d1.w * d1.w));
            sq += dpp_mov<0xB1>(sq); sq += dpp_mov<0x4E>(sq); sq += dpp_mov<0x141>(sq);
            const float rstd = __builtin_amdgcn_rsqf(sq * (1.0f / 64.0f) + 64e-5f);
            const f32x4 g0 = *(const f32x4*)(p.gn_g + h * 64 + pc), g1 = *(const f32x4*)(p.gn_g + h * 64 + pc + 4), b0 = *(const f32x4*)(p.gn_b + h * 64 + pc), b1 = *(const f32x4*)(p.gn_b + h * 64 + pc + 4);
            const f32x4 v0 = *(const LAS f32x4*)(V + 320 + pc), v1 = *(const LAS f32x4*)(V + 320 + pc + 4), q0 = *(const LAS f32x4*)(V + 384 + pc), q1 = *(const LAS f32x4*)(V + 384 + pc + 4);
            const f32x4 r0 = *(const LAS f32x4*)(V + 256 + pc), r1 = *(const LAS f32x4*)(V + 256 + pc + 4), k0_ = *(const LAS f32x4*)(V + 192 + pc), k1_ = *(const LAS f32x4*)(V + 192 + pc + 4);
            const f32x4 c0 = *(const f32x4*)(p.r_k + h * 64 + pc), c1 = *(const f32x4*)(p.r_k + h * 64 + pc + 4);
            const f32x4 t0 = r0 * k0_ * c0, t1 = r1 * k1_ * c1;
            float rk = ((t0.x + t0.y) + (t0.z + t0.w)) + ((t1.x + t1.y) + (t1.z + t1.w));
            rk += dpp_mov<0xB1>(rk); rk += dpp_mov<0x4E>(rk); rk += dpp_mov<0x141>(rk);
            const f32x4 y0 = ((d0 * rstd) * g0 + b0 + v0 * rk) * q0, y1 = ((d1 * rstd) * g1 + b1 + v1 * rk) * q1;
            u32x4 wv; wv.x = pk2hw(y0.x, y0.y); wv.y = pk2hw(y0.z, y0.w); wv.z = pk2hw(y1.x, y1.y); wv.w = pk2hw(y1.z, y1.w);
            const size_t row = row0 + sc * TS + pst;
            *(u32x4*)(p.mix + row * DM + 1024 + h * 64 + pc) = wv;
        }
    }
#undef SCAN_LOAD
    if (MODE != 2) {
#pragma unroll
        for (int r = 0; r < 4; ++r) {
            f32x4* du = (f32x4*)(p.cs + ((size_t)((chain * NCH + c) * 2 + MODE) * 4096 + (4 * rg + r) * 64 + 16 * cgi));
#pragma unroll
            for (int i = 0; i < 4; ++i) du[i] = (f32x4){su[r][2 * i].x, su[r][2 * i].y, su[r][2 * i + 1].x, su[r][2 * i + 1].y};
        }
    }
}

__device__ __forceinline__ void scan_combine(LAS float* L, const float* cs, float* sinit, int chain, int tid) {
#define SC_LDS_BARRIER() do { asm volatile("s_waitcnt lgkmcnt(0)" ::: "memory"); __builtin_amdgcn_s_barrier(); asm volatile("" ::: "memory"); } while (0)
    LAS float* Sl = L; LAS float* Pl = L + 64 * 68;
    const int i = tid & 63, w8 = __builtin_amdgcn_readfirstlane(tid >> 6);
    const float* base = cs + (size_t)(chain * NCH) * 2 * 4096;
    f32x4 pP0 = *(const f32x4*)(base + 4096 + tid * 8), pP1 = *(const f32x4*)(base + 4096 + tid * 8 + 4);
    f32x4 pU0 = *(const f32x4*)(base + i * 64 + 8 * w8), pU1 = *(const f32x4*)(base + i * 64 + 8 * w8 + 4);
    f32x4 a0 = {0.f, 0.f, 0.f, 0.f}, a1 = {0.f, 0.f, 0.f, 0.f};
#pragma unroll 1
    for (int c = 0; c < NCH - 1; ++c) {
        *(LAS f32x4*)(Sl + i * 68 + 8 * w8) = a0; *(LAS f32x4*)(Sl + i * 68 + 8 * w8 + 4) = a1;
        *(LAS f32x4*)(Pl + tid * 8) = pP0; *(LAS f32x4*)(Pl + tid * 8 + 4) = pP1;
        f32x4 u0 = pU0, u1 = pU1;
        SC_LDS_BARRIER();
        if (c + 1 < NCH - 1) { const float* nb = base + (size_t)(c + 1) * 2 * 4096;
            pP0 = *(const f32x4*)(nb + 4096 + tid * 8); pP1 = *(const f32x4*)(nb + 4096 + tid * 8 + 4);
            pU0 = *(const f32x4*)(nb + i * 64 + 8 * w8); pU1 = *(const f32x4*)(nb + i * 64 + 8 * w8 + 4); }
        f32x4 srow[16];
#pragma unroll
        for (int k = 0; k < 16; ++k) srow[k] = *(const LAS f32x4*)(Sl + i * 68 + 4 * k);
#pragma unroll
        for (int j = 0; j < 64; ++j) { const float sij = srow[j >> 2][j & 3];
            const f32x4 p0 = *(const LAS f32x4*)(Pl + j * 64 + 8 * w8), p1 = *(const LAS f32x4*)(Pl + j * 64 + 8 * w8 + 4); u0 += p0 * sij; u1 += p1 * sij; }
        a0 = u0; a1 = u1;
        SC_LDS_BARRIER();
        float* so = sinit + (size_t)(chain * NCH + c + 1) * 4096 + i * 64 + 8 * w8;
        *(f32x4*)so = a0; *(f32x4*)(so + 4) = a1;
    }
#undef SC_LDS_BARRIER
}

constexpr int KS_STRIDE = 72, VT_STRIDE = 288;
constexpr int ATT_KS_OFF = 0, ATT_VT_OFF = 256 * KS_STRIDE * 2;
constexpr int ATT_UNITS = 12288;
struct AttnUnit { int b, h, g, dl, res, n, u; };
__device__ __forceinline__ AttnUnit attn_decode(int u) {
    AttnUnit a; a.u = u; const int bh = u / 384, rest = u % 384; a.g = rest / 128; const int rn = rest % 128;
    a.b = bh >> 4; a.h = bh & 15; a.dl = (a.g == 0) ? 1 : (a.g == 1 ? 4 : 16);
    const int nbk = 128 / a.dl; a.res = rn / nbk; a.n = rn % nbk; return a;
}
__device__ __forceinline__ void attn_load(const AttnUnit& a, const bf16_t* proj, int tid, u32x4 (&kv)[4], u32x4 (&vv)[4]) {
#pragma unroll
    for (int ps = 0; ps < 4; ++ps) {
        const int idx = ps * 512 + tid, key = idx >> 3, seg = idx & 7;
        const int sub = (a.n - 1) * 128 + key, subc = sub < 0 ? 0 : sub;
        const size_t row = (size_t)a.b * SEQ + (size_t)subc * a.dl + a.res; const bf16_t* pr = proj + row * LDP + a.h * 64 + seg * 8;
        kv[ps] = *(const u32x4*)(pr + PC_K); vv[ps] = *(const u32x4*)(pr + PC_V);
    }
}
__device__ __forceinline__ void attn_stage(LAS unsigned char* lds, int tid, int n, const u32x4 (&kv)[4], const u32x4 (&vv)[4]) {
    LAS bf16_t* Ks = (LAS bf16_t*)(lds + ATT_KS_OFF);
    LAS bf16_t* Vt = (LAS bf16_t*)(lds + ATT_VT_OFF);
#pragma unroll
    for (int ps = 0; ps < 4; ++ps) {
        const int idx = ps * 512 + tid, key = idx >> 3, seg = idx & 7;
        u32x4 k4 = kv[ps], v4 = vv[ps];
        if (n == 0 && ps < 2) { k4 = (u32x4){0u, 0u, 0u, 0u}; v4 = (u32x4){0u, 0u, 0u, 0u}; }
        *(LAS u32x4*)(Ks + key * KS_STRIDE + seg * 8) = k4;
        LAS bf16_t* vd = Vt + (seg * 8) * VT_STRIDE + (key ^ (seg << 2));
        vd[0 * VT_STRIDE] = (bf16_t)(v4.x & 0xffffu); vd[1 * VT_STRIDE] = (bf16_t)(v4.x >> 16);
        vd[2 * VT_STRIDE] = (bf16_t)(v4.y & 0xffffu); vd[3 * VT_STRIDE] = (bf16_t)(v4.y >> 16);
        vd[4 * VT_STRIDE] = (bf16_t)(v4.z & 0xffffu); vd[5 * VT_STRIDE] = (bf16_t)(v4.z >> 16);
        vd[6 * VT_STRIDE] = (bf16_t)(v4.w & 0xffffu); vd[7 * VT_STRIDE] = (bf16_t)(v4.w >> 16);
    }
}
struct AttnOut { unsigned c01[4], c23[4]; float lsev; };
__device__ __forceinline__ void attn_compute(LAS unsigned char* lds, const AttnUnit& a, const bf16x8 (&qf)[2], AttnOut& o, int tid) {
    const int lane = tid & 63, w = __builtin_amdgcn_readfirstlane(tid >> 6), r = lane & 15, q = lane >> 4;
    const int n = a.n, dl = a.dl, res = a.res, b = a.b, h = a.h, g = a.g;
    const LAS bf16_t* Ks = (const LAS bf16_t*)(lds + ATT_KS_OFF);
    const LAS bf16_t* Vt = (const LAS bf16_t*)(lds + ATT_VT_OFF);
    f32x4 sacc[9];
#pragma unroll
    for (int kt = 0; kt < 9; ++kt) {
        sacc[kt] = (f32x4){0.f, 0.f, 0.f, 0.f};
#pragma unroll
        for (int ks = 0; ks < 2; ++ks) {
            const bf16x8 kf = *(const LAS bf16x8*)(Ks + (16 * w + 16 * kt + r) * KS_STRIDE + 32 * ks + 8 * q);
            sacc[kt] = __builtin_amdgcn_mfma_f32_16x16x32_bf16(kf, qf[ks], sacc[kt], 0, 0, 0);
        }
    }
    float mx = -INFINITY;
#pragma unroll
    for (int j = 0; j < 4; ++j) { if (4 * q + j < r) sacc[0][j] = -INFINITY; if (4 * q + j > r) sacc[8][j] = -INFINITY; }
    if (n == 0) {
#pragma unroll
        for (int kt = 0; kt < 8; ++kt)
#pragma unroll
            for (int j = 0; j < 4; ++j) if (16 * w + 16 * kt + 4 * q + j < 128) sacc[kt][j] = -INFINITY;
    }
#pragma unroll
    for (int kt = 0; kt < 9; ++kt)
#pragma unroll
        for (int j = 0; j < 4; ++j) mx = fmaxf(mx, sacc[kt][j]);
    mx = fmaxf(mx, __shfl_xor(mx, 16)); mx = fmaxf(mx, __shfl_xor(mx, 32));
    float lsum = 0.f;
    const float mxl = mx * 1.44269504f;
#pragma unroll
    for (int kt = 0; kt < 9; ++kt)
#pragma unroll
        for (int j = 0; j < 4; ++j) { const float pv = __builtin_amdgcn_exp2f(__builtin_fmaf(sacc[kt][j], 1.44269504f, -mxl)); sacc[kt][j] = pv; lsum += pv; }
    lsum += __shfl_xor(lsum, 16); lsum += __shfl_xor(lsum, 32);
    const LAS bf16_t* vlo[4]; const LAS bf16_t* vhi[4];
#pragma unroll
    for (int dt = 0; dt < 4; ++dt) { const int d = 16 * dt + r, sw = (d >> 3) << 2, kb = 16 * w + 4 * q;
        vlo[dt] = Vt + d * VT_STRIDE + (kb ^ sw); vhi[dt] = Vt + d * VT_STRIDE + ((kb + 16) ^ sw); }
    f32x4 oacc[4];
#pragma unroll
    for (int dt = 0; dt < 4; ++dt) oacc[dt] = (f32x4){0.f, 0.f, 0.f, 0.f};
#pragma unroll
    for (int kp = 0; kp < 5; ++kp) {
        u32x4 pw;
        pw.x = pk2hw(sacc[2 * kp][0], sacc[2 * kp][1]); pw.y = pk2hw(sacc[2 * kp][2], sacc[2 * kp][3]);
        if (kp < 4) { pw.z = pk2hw(sacc[2 * kp + 1][0], sacc[2 * kp + 1][1]); pw.w = pk2hw(sacc[2 * kp + 1][2], sacc[2 * kp + 1][3]); } else { pw.z = 0u; pw.w = 0u; }
        const bf16x8 pf = __builtin_bit_cast(bf16x8, pw);
#pragma unroll
        for (int dt = 0; dt < 4; ++dt) {
            const s16x4 lo = *(const LAS s16x4*)(vlo[dt] + 32 * kp), hi = *(const LAS s16x4*)(vhi[dt] + 32 * kp);
            const bf16x8 vf = __builtin_shufflevector(lo, hi, 0, 1, 2, 3, 4, 5, 6, 7);
            oacc[dt] = __builtin_amdgcn_mfma_f32_16x16x32_bf16(pf, vf, oacc[dt], 0, 0, 0);
        }
    }
    const float linv = __builtin_amdgcn_rcpf(lsum);
#pragma unroll
    for (int j = 0; j < 4; ++j) {
        const float li = __shfl(linv, 4 * q + j);
        o.c01[j] = pk2hw(oacc[0][j] * li, oacc[1][j] * li); o.c23[j] = pk2hw(oacc[2][j] * li, oacc[3][j] * li);
    }
    o.lsev = mx + __logf(lsum);
}
__device__ __forceinline__ void attn_store(const AttnUnit& a, const AttnOut& o, bf16_t* op01, bf16_t* op2, float* lse, int tid) {
    const int lane = tid & 63, w = __builtin_amdgcn_readfirstlane(tid >> 6), r = lane & 15, q = lane >> 4;
    bf16_t* ob = (a.g == 2) ? op2 : (op01 + (size_t)a.g * T * 1024);
#pragma unroll
    for (int j = 0; j < 4; ++j) {
        const int qs2 = a.n * 128 + 16 * w + 4 * q + j;
        const size_t orow = (size_t)a.b * SEQ + (size_t)qs2 * a.dl + a.res;
        bf16_t* op_ = ob + orow * 1024 + a.h * 64 + r;
        op_[0] = (bf16_t)(o.c01[j] & 0xffffu); op_[16] = (bf16_t)(o.c01[j] >> 16); op_[32] = (bf16_t)(o.c23[j] & 0xffffu); op_[48] = (bf16_t)(o.c23[j] >> 16);
    }
    if (q == 0) lse[(size_t)a.u * 128 + 16 * w + r] = o.lsev;
}
__device__ __forceinline__ void attn_phase(LAS unsigned char* lds, int ubeg, int ustride, int ucnt, const bf16_t* proj, bf16_t* op01, bf16_t* op2, float* lse, int tid) {
#define ATT_LDS_BARRIER() do { asm volatile("s_waitcnt lgkmcnt(0)" ::: "memory"); __builtin_amdgcn_s_barrier(); asm volatile("" ::: "memory"); } while (0)
    LAS bf16_t* Vt = (LAS bf16_t*)(lds + ATT_VT_OFF);
    const int lane = tid & 63, w = __builtin_amdgcn_readfirstlane(tid >> 6), r = lane & 15, q = lane >> 4;
    for (int idx = tid; idx < 64 * 16; idx += 512) { const int d = idx >> 4, cc = idx & 15; *(LAS unsigned*)(Vt + d * VT_STRIDE + 256 + 2 * cc) = 0u; }
    __syncthreads();
    if (ucnt <= 0) return;
    u32x4 kv[4], vv[4]; bf16x8 qn[2];
#define ATT_LOADQ(dst, au) do { const size_t qrow_ = (size_t)(au).b * SEQ + (size_t)((au).n * 128 + 16 * w + r) * (au).dl + (au).res; \
        dst[0] = *(const bf16x8*)(proj + qrow_ * LDP + PC_Q + (au).h * 64 + 8 * q); dst[1] = *(const bf16x8*)(proj + qrow_ * LDP + PC_Q + (au).h * 64 + 32 + 8 * q); } while (0)
    { const AttnUnit a0 = attn_decode(ubeg); ATT_LOADQ(qn, a0); attn_load(a0, proj, tid, kv, vv); }
    AttnOut o;
#pragma unroll
    for (int j = 0; j < 4; ++j) { o.c01[j] = 0u; o.c23[j] = 0u; }
    o.lsev = 0.f;
    for (int i = 0; i < ucnt; ++i) {
        const AttnUnit a0 = attn_decode(ubeg + i * ustride);
        attn_stage(lds, tid, a0.n, kv, vv);
        if (i > 0) { const AttnUnit ap = attn_decode(ubeg + (i - 1) * ustride); attn_store(ap, o, op01, op2, lse, tid); }
        bf16x8 qf[2]; qf[0] = qn[0]; qf[1] = qn[1];
        { const int inext = (i + 1 < ucnt) ? i + 1 : i; const AttnUnit a1 = attn_decode(ubeg + inext * ustride); ATT_LOADQ(qn, a1); attn_load(a1, proj, tid, kv, vv); }
        ATT_LDS_BARRIER();
        attn_compute(lds, a0, qf, o, tid);
        ATT_LDS_BARRIER();
    }
    { const AttnUnit ap = attn_decode(ubeg + (ucnt - 1) * ustride); attn_store(ap, o, op01, op2, lse, tid); }
#undef ATT_LDS_BARRIER
#undef ATT_LOADQ
    __syncthreads();
}

__global__ void __launch_bounds__(512, 2) mk_fwd(Args a) {
    extern __shared__ __attribute__((aligned(16))) unsigned char lds_raw[];
    cg::grid_group grid = cg::this_grid();
    LAS unsigned char* lds = (LAS unsigned char*)lds_raw;
    const int G = gridDim.x, bx = blockIdx.x;
    const int NGW = G * 8, NGT = G * 512;
#define PH_IDS const int tid = opaque_tid(wave_s), lane = tid & 63, wave = wave_s, gw = bx * 8 + wave, gt = bx * 512 + tid; (void)lane; (void)gw; (void)gt; (void)wave; PH_WS
#define PH_WS __attribute__((address_space(1))) unsigned char* ws = (__attribute__((address_space(1))) unsigned char*)a.ws; asm volatile("" : "+s"(ws)); float* const outp = a.out
#define ctl ((unsigned*)(ws + WS_CTL))
#define x_in ((const float*)a.in[I_X])
#define adap ((float*)(ws + WS_ADAP))
#define ada ((float*)(ws + WS_ADA))
#define rope ((float*)(ws + WS_ROPE))
#define kkn ((float*)(ws + WS_KKN))
#define lse ((float*)(ws + WS_LSE))
#define WdT ((bf16_t*)(ws + WS_WLORA))
#define WaT (WdT + 1024 * 256)
#define WgT (WdT + 2 * 1024 * 256)
#define WinT ((bf16_t*)(ws + WS_WIN))
#define WoutT ((bf16_t*)(ws + WS_WOUT))
#define WguT ((bf16_t*)(ws + WS_WGU))
#define WdownT ((bf16_t*)(ws + WS_WDOWN))
#define lact ((bf16_t*)(ws + WS_LACT))
#define cs ((float*)(ws + WS_CS))
#define sinit ((float*)(ws + WS_SINIT))
#define proj ((bf16_t*)(ws + WS_PROJ))
#define hid ((bf16_t*)(ws + WS_PROJ))
#define hbuf ((bf16_t*)(ws + WS_HBUF))
#define mix ((bf16_t*)(ws + WS_MIX))
#define op2 ((bf16_t*)(ws + WS_OP2))
#define lz ((_Float16*)outp)
#define lbias ((float*)(ws + WS_ADA + 512 * 1024))
#define IN(k) (a.ph_lo <= (k) && (k) < a.ph_hi)
#ifndef MK_PROBE
#define MK_PROBE -1
#endif
#define REPS(k) for (int rep_ = 0; rep_ < ((MK_PROBE == (k)) ? 2 : 1); ++rep_)
    volatile LAS unsigned* bst = (volatile LAS unsigned*)(lds + 140032);
    const int wave_s = __builtin_amdgcn_readfirstlane((int)threadIdx.x >> 6);
    if (threadIdx.x == 0) { bst[0] = 0u; bst[1] = 0u; }
    __syncthreads();
    XcdBarrier xbar; xbar.bar = (unsigned*)(a.ws + WS_CTL) + 4096; xbar.x = 0; xbar.st = bst;
    if (a.ph_hi - a.ph_lo > 1) xbar = xcd_barrier_post((unsigned*)(a.ws + WS_CTL) + 4096, bst, threadIdx.x == 0);
#define SYNC(k) do { if (IN(k) && IN((k) + 1)) { if ((k) == 0 && a.ph_lo < 0) grid.sync(); else xcd_barrier(xbar, wave_s); } } while (0)

    if (IN(0)) {
        PH_IDS;
        LAS float* scr = (LAS float*)(lds + wave * 16384);
        constexpr int I_IN = 32 * 201, I_OUT = 32 * 64, I_G = 32 * 176, I_D = 88 * 64, I_LD = 4 * 32, I_LG = 4 * 32;
        constexpr int NITEMS = I_IN + I_OUT + 2 * I_G + I_D + 2 * I_LD + I_LG;
        for (int it = gw; it < NITEMS; it += NGW) {
            int r_ = it;
            if (r_ < I_IN) { const int kb = r_ / 201, nb = r_ % 201; transpose_item((const float*)a.in[I_WIN], DM, NPROJ, WinT, DM, 32 * nb, 64 * kb, 32 * nb, scr, lane); continue; } r_ -= I_IN;
            if (r_ < I_OUT) { const int kb = r_ / 64, nb = r_ % 64; transpose_item((const float*)a.in[I_WOUT], DM, DM, WoutT, DM, 32 * nb, 64 * kb, 32 * nb, scr, lane); continue; } r_ -= I_OUT;
            if (r_ < I_G) { const int kb = r_ / 176, nb = r_ % 176, n0 = 32 * nb; transpose_item((const float*)a.in[I_FG], DM, FF, WguT, DM, 256 * (n0 / 128) + (n0 % 128), 64 * kb, n0, scr, lane); continue; } r_ -= I_G;
            if (r_ < I_G) { const int kb = r_ / 176, nb = r_ % 176, n0 = 32 * nb; transpose_item((const float*)a.in[I_FU], DM, FF, WguT, DM, 256 * (n0 / 128) + 128 + (n0 % 128), 64 * kb, n0, scr, lane); continue; } r_ -= I_G;
            if (r_ < I_D) { const int kb = r_ / 64, nb = r_ % 64; transpose_item((const float*)a.in[I_FD], FF, DM, WdownT, FF, 32 * nb, 64 * kb, 32 * nb, scr, lane); continue; } r_ -= I_D;
            if (r_ < I_LD) { const int kb = r_ / 32, nb = r_ % 32; transpose_item((const float*)a.in[I_WDEC], 64, 1024, WdT, 256, 32 * nb, 64 * kb, 32 * nb, scr, lane); continue; } r_ -= I_LD;
            if (r_ < I_LD) { const int kb = r_ / 32, nb = r_ % 32; transpose_item((const float*)a.in[I_WICLR], 64, 1024, WaT, 256, 32 * nb, 64 * kb, 32 * nb, scr, lane); continue; } r_ -= I_LD;
            { const int kb = r_ / 32, nb = r_ % 32; transpose_item((const float*)a.in[I_WGATE], 160, 1024, WgT, 256, 32 * nb, 64 * kb, 32 * nb, scr, lane); }
        }
        { u32x4* z = (u32x4*)(WinT + (size_t)NPROJ * DM); for (int idx = gt; idx < (LDP - NPROJ) * DM * 2 / 16; idx += NGT) z[idx] = (u32x4){0u, 0u, 0u, 0u}; }
        for (int idx = gt; idx < 3072; idx += NGT) lbias[idx] = (idx < 1024) ? ((const float*)a.in[I_W0])[idx] : (idx < 2048) ? ((const float*)a.in[I_A0])[idx - 1024] : 0.f;
        {
            const float* wada = (const float*)a.in[I_WADA]; const float* cvec = (const float*)a.in[I_C];
            for (int it = bx; it < 768; it += G) {
                const int ks = it / 6, cb = it % 6, n = cb * 2048 + tid * 4;
                f32x4 s0 = {0.f, 0.f, 0.f, 0.f}, s1 = {0.f, 0.f, 0.f, 0.f};
#pragma unroll
                for (int kk = 0; kk < 16; ++kk) { const int k = ks * 16 + kk; const f32x4 wv = *(const f32x4*)(wada + (size_t)k * ADA_N + n);
                    const float c0 = cvec[k], c1 = cvec[DM + k]; const float e0 = c0 * sigmoidf_(c0), e1 = c1 * sigmoidf_(c1); s0 += wv * e0; s1 += wv * e1; }
                *(f32x4*)(adap + (size_t)(ks * 2 + 0) * ADA_N + n) = s0; *(f32x4*)(adap + (size_t)(ks * 2 + 1) * ADA_N + n) = s1;
            }
        }
        {
            const int* pos = (const int*)a.in[I_POS];
            for (int idx = gt; idx < T * 8; idx += NGT) {
                const int row = idx >> 3, i = idx & 7;
                const float inv = (float)exp(-(double)i * 0.125 * 13.122363377404328);
                const float ang = (float)pos[row] * inv;
                const double ad = (double)ang; const double nq = rint(ad * 0.6366197723675814); const double rr = ad - nq * 1.5707963267948966; const double r2 = rr * rr;
                const double sn = rr * (1.0 + r2 * (-1.0 / 6 + r2 * (1.0 / 120 + r2 * (-1.0 / 5040 + r2 * (1.0 / 362880 + r2 * (-1.0 / 39916800 + r2 * (1.0 / 6227020800.0)))))));
                const double cn = 1.0 + r2 * (-0.5 + r2 * (1.0 / 24 + r2 * (-1.0 / 720 + r2 * (1.0 / 40320 + r2 * (-1.0 / 3628800 + r2 * (1.0 / 479001600 + r2 * (-1.0 / 87178291200.0)))))));
                const int qd = ((int)nq) & 3;
                const double cv = (qd == 0) ? cn : (qd == 1) ? -sn : (qd == 2) ? -cn : sn;
                const double sv = (qd == 0) ? sn : (qd == 1) ? cn : (qd == 2) ? -sn : -cn;
                rope[(size_t)row * 16 + i] = (float)cv; rope[(size_t)row * 16 + 8 + i] = (float)sv;
            }
        }
    }
    SYNC(0);
    if (IN(1)) {
        PH_IDS;
        const float* bada = (const float*)a.in[I_BADA];
        for (int id4 = gt; id4 < 4 * 2 * ADA_N; id4 += NGT) {
            const int idx = id4 >> 2, part = id4 & 3, b = idx / ADA_N, n = idx % ADA_N;
            float s0 = 0.f, s1 = 0.f, s2 = 0.f, s3 = 0.f;
#pragma unroll
            for (int k = 0; k < 32; k += 4) {
                s0 += adap[(size_t)((part * 32 + k + 0) * 2 + b) * ADA_N + n]; s1 += adap[(size_t)((part * 32 + k + 1) * 2 + b) * ADA_N + n];
                s2 += adap[(size_t)((part * 32 + k + 2) * 2 + b) * ADA_N + n]; s3 += adap[(size_t)((part * 32 + k + 3) * 2 + b) * ADA_N + n]; }
            float sm = (s0 + s1) + (s2 + s3);
            sm += __shfl_xor(sm, 1); sm += __shfl_xor(sm, 2);
            if (part == 0) ada[idx] = sm + bada[n];
        }
    }
    SYNC(1);
    if (IN(2)) { PH_IDS; norm_rows_mod(x_in, hbuf, (const float*)a.in[I_N1G], ada + 1 * DM, ada + 0 * DM, gw, NGW, lane); }
    SYNC(2);
    REPS(3) if (IN(3)) {
        PH_WS;
        pg8::Gemm g{hbuf, WinT, T, LDP, DM, DM, DM, 0, 0}; pg8::StaticOrder S; S.init(T, LDP, G, bx);
        pg8::EpiProj E{proj, LDP, rope};
        pg8::gemm_phase<pg8::EpiProj, pg8::StaticOrder>(lds, g, S, E, wave_s);
    }
    SYNC(3);
    if (IN(4)) {
        PH_IDS;
        const float* mu = (const float*)a.in[I_MU]; const float* k_k = (const float*)a.in[I_KK];
        for (int row = gw; row < T; row += NGW) {
            const bool first = (row % SEQ) == 0;
            const bf16_t* pr = proj + (size_t)row * LDP; const bf16_t* pp = pr - LDP;
            { const int c0 = 16 * lane; float ss = 0.f;
              const u32x4 k0 = *(const u32x4*)(pr + PC_RK + c0), k1 = *(const u32x4*)(pr + PC_RK + c0 + 8);
              u32x4 p0 = {0u, 0u, 0u, 0u}, p1 = {0u, 0u, 0u, 0u};
              if (!first) { p0 = *(const u32x4*)(pp + PC_RK + c0); p1 = *(const u32x4*)(pp + PC_RK + c0 + 8); }
#pragma unroll
              for (int e = 0; e < 16; ++e) {
                  const unsigned cw = (e < 8) ? k0[e >> 1] : k1[(e - 8) >> 1], pw = (e < 8) ? p0[e >> 1] : p1[(e - 8) >> 1];
                  const float kc = (e & 1) ? __uint_as_float(cw & 0xffff0000u) : __uint_as_float(cw << 16);
                  const float kp = (e & 1) ? __uint_as_float(pw & 0xffff0000u) : __uint_as_float(pw << 16);
                  const float k = kc + (kp - kc) * mu[1024 + c0 + e];
                  const float t = k * k_k[c0 + e]; ss += t * t; }
              ss += __shfl_xor(ss, 1); ss += __shfl_xor(ss, 2);
              if ((lane & 3) == 0) kkn[(size_t)row * 16 + (lane >> 2)] = 1.0f / fmaxf(sqrtf(ss), 1e-12f); }
#pragma unroll
            for (int i = 0; i < 12; ++i) {
                const int d = lane + 64 * i; int src = -1, mode = 0;
                if (d < 64) { src = PC_WL + d; mode = 0; } else if (d >= 256 && d < 320) { src = PC_AL + (d - 256); mode = 1; } else if (d >= 512 && d < 672) { src = PC_GL + (d - 512); mode = 2; }
                float val = 0.f;
                if (src >= 0) { const float yc = bf2f(pr[src]); const float yp = first ? 0.f : bf2f(pp[src]); const float y = yc + (yp - yc) * mu[src - 3072];
                    val = (mode == 0) ? tanhf(y) : (mode == 1) ? y : sigmoidf_(y); }
                lact[(size_t)row * 768 + d] = (bf16_t)f2bf(val);
            }
        }
    }
    SYNC(4);
    if (IN(5)) {
        PH_WS; pg8::StaticOrder S; S.init(T, 3072, G, bx);
        pg8::Gemm g{lact, WdT, T, 3072, 256, 768, 256, 256, 128};
        pg8::EpiLora E{lz, lbias};
        pg8::gemm_phase<pg8::EpiLora, pg8::StaticOrder>(lds, g, S, E, wave_s);
    }
    SYNC(5);
#define MK_SCANPTRS ScanPtrs sp{proj, lz, kkn, (const float*)a.in[I_MU], (const float*)a.in[I_KK], (const float*)a.in[I_KA], (const float*)a.in[I_RK], (const float*)a.in[I_GNG], (const float*)a.in[I_GNB], cs, sinit, mix}
    REPS(6) if (IN(6)) {
        PH_IDS; MK_SCANPTRS;
        LAS float* W = (LAS float*)(lds + wave * 16384);
        for (int it = gw; it < 2 * NCHAIN * NCH; it += NGW) { const int which = it / (NCHAIN * NCH), cc = it % (NCHAIN * NCH);
            if (which == 0) scan_item<0, 8>(W, sp, cc / NCH, cc % NCH, lane); else scan_item<1, 8>(W, sp, cc / NCH, cc % NCH, lane); }
    }
    SYNC(6);
    REPS(7) if (IN(7)) {
        PH_IDS;
        if (bx < NCHAIN) { scan_combine((LAS float*)lds, cs, sinit, bx, tid); __syncthreads(); }
        int ubeg, ustride, ucnt;
        if (G == 256) { const int j = bx - NCHAIN;
            if (bx < NCHAIN) { ubeg = 192 * 51 + 32 * 50 + bx * 28; ucnt = 28; } else if (j < 192) { ubeg = j * 51; ucnt = 51; } else { ubeg = 192 * 51 + (j - 192) * 50; ucnt = 50; } ustride = 1; }
        else { ubeg = bx; ustride = G; ucnt = (ATT_UNITS - bx + G - 1) / G; }
        attn_phase(lds, ubeg, ustride, ucnt, proj, hbuf, op2, lse, tid);
    }
    SYNC(7);
    REPS(8) if (IN(8)) {
        PH_IDS; MK_SCANPTRS;
        LAS float* W = (LAS float*)(lds + wave * 16384);
        for (int it = gw; it < NCHAIN * NCH; it += NGW) scan_item<2, 8>(W, sp, it / NCH, it % NCH, lane);
        for (int idx = gt; idx < T * 128; idx += NGT) {
            const int row = idx >> 7, c8 = idx & 127, h = c8 >> 3;
            const int bb_ = row / SEQ, s_ = row % SEQ, ub_ = (bb_ * 16 + h) * 384;
            const float l0 = lse[(size_t)(ub_ + 0 * 128 + (s_ >> 7)) * 128 + (s_ & 127)];
            const float l1 = lse[(size_t)(ub_ + 1 * 128 + (s_ & 3) * 32 + (s_ >> 9)) * 128 + ((s_ >> 2) & 127)];
            const float l2 = lse[(size_t)(ub_ + 2 * 128 + (s_ & 15) * 8 + (s_ >> 11)) * 128 + ((s_ >> 4) & 127)];
            const float mxl = fmaxf(l0, fmaxf(l1, l2));
            float w0 = __expf(l0 - mxl), w1 = __expf(l1 - mxl), w2 = __expf(l2 - mxl); const float wi = 1.0f / (w0 + w1 + w2); w0 *= wi; w1 *= wi; w2 *= wi;
            const u32x4 o0 = *(const u32x4*)(hbuf + (size_t)row * 1024 + c8 * 8), o1 = *(const u32x4*)(hbuf + (size_t)T * 1024 + (size_t)row * 1024 + c8 * 8), o2 = *(const u32x4*)(op2 + (size_t)row * 1024 + c8 * 8);
            u32x4 ov;
#pragma unroll
            for (int e = 0; e < 4; ++e) {
                const float lo = w0 * __uint_as_float(o0[e] << 16) + w1 * __uint_as_float(o1[e] << 16) + w2 * __uint_as_float(o2[e] << 16);
                const float hi = w0 * __uint_as_float(o0[e] & 0xffff0000u) + w1 * __uint_as_float(o1[e] & 0xffff0000u) + w2 * __uint_as_float(o2[e] & 0xffff0000u);
                ov[e] = pk2(lo, hi); }
            *(u32x4*)(mix + (size_t)row * DM + c8 * 8) = ov;
        }
    }
    SYNC(8);
    if (IN(9)) {
        PH_WS;
        pg8::Gemm g{mix, WoutT, T, DM, DM, DM, DM, 0, 0};
        if (G == 256) {
            pg8::PanelOrder S{bx};
            pg8::EpiResidNorm<true> E{x_in, outp, ada + 2 * DM, (const float*)a.in[I_N2G], (unsigned*)(ws + WS_ADAP + 1 * MiB), ctl + 16384 + 8192, (LAS float*)(lds + 131072), hbuf, ada};
            pg8::gemm_phase<pg8::EpiResidNorm<true>, pg8::PanelOrder>(lds, g, S, E, wave_s);
        } else {
            pg8::StaticOrder S; S.init(T, DM, G, bx);
            pg8::EpiResid E{x_in, outp, ada + 2 * DM};
            pg8::gemm_phase<pg8::EpiResid, pg8::StaticOrder>(lds, g, S, E, wave_s);
        }
    }
    SYNC(9);
    if (IN(10) && G != 256) { PH_IDS; norm_rows_mod(outp, hbuf, (const float*)a.in[I_N2G], ada + 4 * DM, ada + 3 * DM, gw, NGW, lane); }
    if (G != 256) SYNC(10);
    REPS(11) if (IN(11)) {
        PH_WS;
        pg8::Gemm g{hbuf, WguT, T, 2 * FF, DM, DM, DM, 0, 0}; pg8::StaticOrder S; S.init(T, 2 * FF, G, bx);
        pg8::EpiSwiglu E{hid};
        pg8::gemm_phase<pg8::EpiSwiglu, pg8::StaticOrder>(lds, g, S, E, wave_s);
    }
    SYNC(11);
    if (IN(12)) {
        PH_WS;
        pg8::Gemm g{hid, WdownT, T, DM, FF, FF, FF, 0, 0};
        if (G == 256) {
            pg8::PanelOrder S{bx};
            pg8::EpiResidNorm<false> E{outp, outp, ada + 5 * DM, (const float*)a.in[I_NFG], (unsigned*)(ws + WS_ADAP), ctl + 16384, (LAS float*)(lds + 131072), nullptr, ada};
            pg8::gemm_phase<pg8::EpiResidNorm<false>, pg8::PanelOrder>(lds, g, S, E, wave_s);
        } else {
            pg8::StaticOrder S; S.init(T, DM, G, bx);
            pg8::EpiResid E{outp, outp, ada + 5 * DM};
            pg8::gemm_phase<pg8::EpiResid, pg8::StaticOrder>(lds, g, S, E, wave_s);
        }
    }
    if (G != 256) SYNC(12);
    if (IN(13) && G != 256) {
        PH_IDS;
        const float* gf = (const float*)a.in[I_NFG];
        for (int row = gw; row < T; row += NGW) {
            f32x4* xr = (f32x4*)(outp + (size_t)row * DM) + lane;
            f32x4 v[8]; float ss = 0.f;
#pragma unroll
            for (int j = 0; j < 8; ++j) { v[j] = xr[64 * j]; ss += (v[j].x * v[j].x + v[j].y * v[j].y) + (v[j].z * v[j].z + v[j].w * v[j].w); }
            const float rstd = 1.0f / sqrtf(wave_sum(ss) * (1.0f / DM) + 1e-6f);
#pragma unroll
            for (int j = 0; j < 8; ++j) { const f32x4 g4 = *(const f32x4*)(gf + 4 * lane + 256 * j); xr[64 * j] = (v[j] * rstd) * g4; }
        }
    }
#undef IN
#undef SYNC
}

#ifndef MK_PER_PHASE
#define MK_PER_PHASE 0
#endif
constexpr int N_PHASES = 14;
extern "C" void kernel_launch(void* const* d_in, const int* in_sizes, int n_in, void* d_out, int out_size, void* d_ws, size_t ws_size, hipStream_t stream) {
    static int grid = 0;
    if (grid == 0) {
        if (n_in != 24 || in_sizes[0] != T * DM || out_size != T * DM || ws_size < WS_END) { fprintf(stderr, "kernel_launch: unexpected shapes: n_in %d in0 %d out %d ws %zu (need %zu)\n", n_in, n_in > 0 ? in_sizes[0] : -1, out_size, ws_size, (size_t)WS_END); grid = -1; return; }
        int dev = 0, cus = 0, per_cu = 0;
        if (hipGetDevice(&dev) != hipSuccess || hipDeviceGetAttribute(&cus, hipDeviceAttributeMultiprocessorCount, dev) != hipSuccess) { fprintf(stderr, "kernel_launch: device query failed\n"); grid = -1; return; }
        if (hipFuncSetAttribute((const void*)mk_fwd, hipFuncAttributeMaxDynamicSharedMemorySize, LDS_BYTES) != hipSuccess) { fprintf(stderr, "kernel_launch: hipFuncSetAttribute failed\n"); grid = -1; return; }
        if (hipOccupancyMaxActiveBlocksPerMultiprocessor(&per_cu, (const void*)mk_fwd, 512, LDS_BYTES) != hipSuccess || per_cu < 1) { fprintf(stderr, "kernel_launch: occupancy query says %d\n", per_cu); per_cu = 1; }
        (void)hipGetLastError();
        grid = cus * per_cu;
    }
    if (grid < 0) return;
    if (hipMemsetAsync((char*)d_ws + WS_CTL, 0, 1 * MiB, stream) != hipSuccess) { fprintf(stderr, "kernel_launch: memset failed\n"); return; }
    Args a{};
    for (int i = 0; i < 24; ++i) a.in[i] = d_in[i];
    a.out = (float*)d_out; a.ws = (unsigned char*)d_ws;
#if MK_PER_PHASE
    for (int ph = 0; ph < N_PHASES; ++ph) {
        a.ph_lo = ph; a.ph_hi = ph + 1;
        hipLaunchKernelGGL(mk_fwd, dim3(grid), dim3(512), LDS_BYTES, stream, a);
    }
#else
    a.ph_lo = 0; a.ph_hi = N_PHASES;
    void* args[] = {&a};
    hipError_t e = hipLaunchCooperativeKernel((const void*)mk_fwd, dim3(grid), dim3(512), args, LDS_BYTES, stream);
    if (e != hipSuccess) fprintf(stderr, "kernel_launch: cooperative launch failed: %s (grid %d)\n", hipGetErrorString(e), grid);
#endif
}
```

```cpp
#include <hip/hip_runtime.h>
#include <hip/hip_cooperative_groups.h>
#include <cstdio>
#include <cstdint>
namespace cg = cooperative_groups;

#define LAS __attribute__((address_space(3)))
typedef unsigned short bf16_t;
typedef short bf16x8 __attribute__((ext_vector_type(8)));
typedef short s16x4 __attribute__((ext_vector_type(4)));
typedef float f32x4 __attribute__((ext_vector_type(4)));
typedef float f32x2 __attribute__((ext_vector_type(2)));
typedef unsigned u32x4 __attribute__((ext_vector_type(4)));
typedef unsigned u32x2 __attribute__((ext_vector_type(2)));

constexpr int BATCH = 2, SEQ = 16384, DM = 2048, T = BATCH * SEQ;
constexpr int NPROJ = 6432, LDP = 6656;
constexpr int FF = 5632;
constexpr int ADA_N = 6 * DM;
constexpr int CL = 256, NCH = SEQ / CL;
constexpr int NCHAIN = BATCH * 16;
constexpr int PC_Q = 0, PC_K = 1024, PC_V = 2048, PC_R = 3072, PC_RK = 4096, PC_RV = 5120, PC_WL = 6144, PC_AL = 6208, PC_GL = 6272;

constexpr size_t MiB = 1u << 20;
constexpr size_t WS_CTL = 0;
constexpr size_t WS_ADAP = 1 * MiB;
constexpr size_t WS_ADA = 14 * MiB;
constexpr size_t WS_ROPE = 15 * MiB;
constexpr size_t WS_KKN = 17 * MiB;
constexpr size_t WS_LSE = 19 * MiB;
constexpr size_t WS_WLORA = 25 * MiB;
constexpr size_t WS_WIN = 27 * MiB;
constexpr size_t WS_WOUT = 53 * MiB;
constexpr size_t WS_WGU = 61 * MiB;
constexpr size_t WS_WDOWN = 105 * MiB;
constexpr size_t WS_LACT = 127 * MiB;
constexpr size_t WS_CS = 175 * MiB;
constexpr size_t WS_SINIT = 239 * MiB;
constexpr size_t WS_PROJ = 271 * MiB;
constexpr size_t WS_HBUF = 687 * MiB;
constexpr size_t WS_MIX = 815 * MiB;
constexpr size_t WS_OP2 = 943 * MiB;
constexpr size_t WS_END = 1007 * MiB;

constexpr int LDS_BYTES = 147456;

__device__ __forceinline__ float bf2f(bf16_t v) { return __uint_as_float((unsigned)v << 16); }
__device__ __forceinline__ unsigned f2bf(float f) { unsigned u = __float_as_uint(f); return (u + 0x7fffu + ((u >> 16) & 1u)) >> 16; }
__device__ __forceinline__ unsigned pk2(float lo, float hi) { return f2bf(lo) | (f2bf(hi) << 16); }
__device__ __forceinline__ unsigned pk2hw(float lo, float hi) { unsigned r; asm volatile("v_cvt_pk_bf16_f32 %0, %1, %2" : "=v"(r) : "v"(lo), "v"(hi)); return r; }
__device__ __forceinline__ float wave_sum(float v) {
#pragma unroll
    for (int o = 1; o < 64; o <<= 1) v += __shfl_xor(v, o);
    return v;
}
__device__ __forceinline__ float sigmoidf_(float x) { return 1.0f / (1.0f + __expf(-x)); }
#define LDS_WAIT() asm volatile("s_waitcnt lgkmcnt(0)" ::: "memory")
__device__ __forceinline__ int opaque_tid(int wave_s) { int t = (wave_s << 6) | (int)__builtin_amdgcn_mbcnt_hi(~0u, __builtin_amdgcn_mbcnt_lo(~0u, 0u)); asm volatile("" : "+v"(t)); return t; }

template <int CTRL> __device__ __forceinline__ float dpp_mov(float v) { return __int_as_float(__builtin_amdgcn_update_dpp(0, __float_as_int(v), CTRL, 0xF, 0xF, true)); }
__device__ __forceinline__ float wave_sum_dpp(float v) {
    v += dpp_mov<0xB1>(v); v += dpp_mov<0x4E>(v); v += dpp_mov<0x141>(v); v += dpp_mov<0x140>(v);
    const int vi = __float_as_int(v);
    return (__int_as_float(__builtin_amdgcn_readlane(vi, 0)) + __int_as_float(__builtin_amdgcn_readlane(vi, 16))) + (__int_as_float(__builtin_amdgcn_readlane(vi, 32)) + __int_as_float(__builtin_amdgcn_readlane(vi, 48)));
}

#define XB_TMO      128
#define XB_XCNT(j)  (256  + 64 * (j))
#define XB_XSUB(j)  (1280 + 64 * (j))
#define XB_XGEN(j)  (2304 + 64 * (j))
#define XB_TOP      3328
#define XB_TOPGEN   3392
#define XCD_BAR_WORDS 3456
#define XB_SPIN_CAP (1u << 22)
__device__ __forceinline__ unsigned xb_ld(unsigned* p)              { return __hip_atomic_load(p, __ATOMIC_RELAXED, __HIP_MEMORY_SCOPE_AGENT); }
__device__ __forceinline__ unsigned xb_add(unsigned* p, unsigned v) { return __hip_atomic_fetch_add(p, v, __ATOMIC_RELAXED, __HIP_MEMORY_SCOPE_AGENT); }
__device__ __forceinline__ unsigned xb_xcc_id() { return (unsigned)__builtin_amdgcn_s_getreg((3 << 11) | 20) & 0xFu; }
#define XB_SPIN(cond, bar) do { unsigned _sp = 0; while (cond) { __builtin_amdgcn_s_sleep(1); \
    if ((++_sp & 255u) == 0u) { if (xb_ld(&(bar)[XB_TMO])) break; if (_sp > XB_SPIN_CAP) { atomicAdd(&(bar)[XB_TMO], 1u); break; } } } } while (0)
struct XcdBarrier { unsigned* bar; unsigned x; volatile LAS unsigned* st; };
__device__ __forceinline__ XcdBarrier xcd_barrier_post(unsigned* bar, volatile LAS unsigned* st, bool leader) {
    XcdBarrier b; b.bar = bar; b.x = xb_xcc_id(); b.st = st;
    if (leader) (void)xb_add(&bar[XB_XCNT(b.x)], 1u);
    return b;
}
__device__ __forceinline__ void xcd_barrier_complete(unsigned* bar, unsigned x, unsigned& nloc, unsigned& nx) {
    const unsigned G = gridDim.x * gridDim.y * gridDim.z;
    unsigned sum, cnt, mine, sp = 0u;
    for (;;) {
        sum = 0u; cnt = 0u; mine = 0u;
#pragma unroll
        for (unsigned j = 0; j < 16; ++j) { const unsigned c = xb_ld(&bar[XB_XCNT(j)]); sum += c; cnt += (c > 0u) ? 1u : 0u; mine = (j == x) ? c : mine; }
        if (sum == G) break;
        __builtin_amdgcn_s_sleep(1);
        if ((++sp & 255u) == 0u) { if (xb_ld(&bar[XB_TMO])) break; if (sp > XB_SPIN_CAP) { atomicAdd(&bar[XB_TMO], 1u); break; } }
    }
    nloc = mine > 0u ? mine : 1u; nx = cnt > 0u ? cnt : 1u;
}
__device__ __forceinline__ void xcd_barrier(const XcdBarrier& b, int wave_s) {
    asm volatile("s_waitcnt vmcnt(0)" ::: "memory");
    __syncthreads();
    if (opaque_tid(wave_s) == 0) {
        unsigned* bar = b.bar;
        __builtin_amdgcn_s_waitcnt(0);
        unsigned nloc = b.st[0], nx = b.st[1];
        if (nloc == 0u) { xcd_barrier_complete(bar, b.x, nloc, nx); b.st[0] = nloc; b.st[1] = nx; }
        const unsigned old = xb_add(&bar[XB_XSUB(b.x)], 1u);
        const unsigned gen = old / nloc;
        if (old + 1u == (gen + 1u) * nloc) {
            __builtin_amdgcn_fence(__ATOMIC_RELEASE, "agent");
            asm volatile("s_waitcnt vmcnt(0)" ::: "memory");
            const unsigned og = xb_add(&bar[XB_TOP], 1u);
            const unsigned tg = og / nx;
            if (og + 1u == (tg + 1u) * nx) xb_add(&bar[XB_TOPGEN], 1u);
            else XB_SPIN(xb_ld(&bar[XB_TOPGEN]) == tg, bar);
            __builtin_amdgcn_fence(__ATOMIC_ACQUIRE, "agent");
            xb_add(&bar[XB_XGEN(b.x)], 1u);
            asm volatile("s_waitcnt vmcnt(0)" ::: "memory");
        } else {
            XB_SPIN(xb_ld(&bar[XB_XGEN(b.x)]) == gen, bar);
            __builtin_amdgcn_fence(__ATOMIC_ACQUIRE, "agent");
            asm volatile("s_waitcnt vmcnt(0)" ::: "memory");
        }
    }
    __syncthreads();
}

namespace pg8 {
#define PG8_LAS __attribute__((address_space(3)))
constexpr int BM = 256, BK = 64, HALF = 128, HTB = HALF * BK * 2, STAGE_BYTES = 8 * HTB, NXCD = 8, WGM = 8;

__host__ __device__ __forceinline__ int lds_byte(int r, int c) { const int st = (r >> 4) * 2 + (c >> 5), rr = r & 15, cc = c & 31, ob = rr * 64 + cc * 2; return st * 1024 + (ob ^ (((ob >> 9) & 1) << 5)); }
__host__ __device__ __forceinline__ void stage_rc(int b, int& R, int& C) { const int st = b / 1024, sb = b % 1024, swz = sb ^ (((sb >> 9) & 1) << 5); R = (st >> 1) * 16 + swz / 64; C = (st & 1) * 32 + (swz % 64) / 2; }
__host__ __device__ __forceinline__ int perm32(int rho) { const int n = rho >> 4, i = rho & 15; return 8 * (i >> 2) + 4 * n + (i & 3); }

struct Unit { int pm, pn; };
struct Gemm { const bf16_t* A; const bf16_t* Bt; int M, N, K, lda, ldb, agrp, kshort; };

struct StaticOrder {
    int nM, nN, nwg, G, c;
    __host__ __device__ void init(int M, int N, int G_, int c_) { nM = M / BM; nN = N / BM; nwg = nM * nN; G = G_; c = c_; }
    __host__ __device__ bool next(int i, Unit& u) const {
        const long L = (long)i * G + c; if (L >= nwg) return false;
        int wgid = (int)L; { const int q = nwg / NXCD, r = nwg % NXCD, xcd = wgid % NXCD, off = wgid / NXCD; wgid = (xcd < r ? xcd * (q + 1) : r * (q + 1) + (xcd - r) * q) + off; }
        const int nig = WGM * nN, gid = wgid / nig, fm = gid * WGM, gsz = (nM - fm) < WGM ? (nM - fm) : WGM;
        u.pm = fm + ((wgid % nig) % gsz); u.pn = (wgid % nig) / gsz; return true;
    }
};

__device__ __forceinline__ unsigned cvt_pk_bf16(float lo, float hi) { unsigned r; asm volatile("v_cvt_pk_bf16_f32 %0, %1, %2" : "=v"(r) : "v"(lo), "v"(hi)); return r; }


struct EpiProj {
    static constexpr bool PERM = true;
    bf16_t* O; int ldc; const float* rope;
    __device__ __forceinline__ void operator()(f32x4 (&acc)[2][2][4][2], const Unit& u, int wr, int wc, int fr, int fq) const {
        const int row0 = u.pm * BM + wr * 64 + fr;
        const float sc = (u.pn < 4) ? 0.125f : 1.0f;
        if (u.pn < 8 && (wc & 1) == 0) {
            const float sg = (fq == 0) ? -1.0f : 1.0f;
            const bool act = fq < 2;
#pragma unroll
            for (int ai = 0; ai < 2; ++ai)
#pragma unroll
                for (int m = 0; m < 4; ++m) {
                    const int row = row0 + ai * HALF + m * 16;
                    const f32x4* rp = (const f32x4*)(rope + (size_t)row * 16);
                    const f32x4 cz[2] = {rp[0], rp[1]}, sz[2] = {rp[2], rp[3]};
#pragma unroll
                    for (int bj = 0; bj < 2; ++bj)
#pragma unroll
                        for (int n = 0; n < 2; ++n) {
                            f32x4 x = acc[ai][bj][m][n], p;
#pragma unroll
                            for (int j = 0; j < 4; ++j) p[j] = __shfl_xor(x[j], 16);
                            const f32x4 y = x * cz[n] + (p * sz[n]) * sg;
                            acc[ai][bj][m][n] = act ? y : x;
                        }
                }
        }
        const int col0 = u.pn * BM + wc * 32 + 8 * fq;
#pragma unroll
        for (int ai = 0; ai < 2; ++ai)
#pragma unroll
            for (int m = 0; m < 4; ++m) { bf16_t* rowp = O + (size_t)(row0 + ai * HALF + m * 16) * ldc + col0;
#pragma unroll
                for (int bj = 0; bj < 2; ++bj) { const f32x4 v0 = acc[ai][bj][m][0] * sc, v1 = acc[ai][bj][m][1] * sc;
                    u32x4 w; w.x = cvt_pk_bf16(v0[0], v0[1]); w.y = cvt_pk_bf16(v0[2], v0[3]); w.z = cvt_pk_bf16(v1[0], v1[1]); w.w = cvt_pk_bf16(v1[2], v1[3]);
                    *(u32x4*)(rowp + bj * HALF) = w; } }
    }
};

typedef _Float16 f16x2 __attribute__((ext_vector_type(2)));
__device__ __forceinline__ unsigned pk_f16(float lo, float hi) { f16x2 h; h.x = (_Float16)lo; h.y = (_Float16)hi; return __builtin_bit_cast(unsigned, h); }
struct EpiLora {
    static constexpr bool PERM = true;
    _Float16* O; const float* bias;
    __device__ __forceinline__ void operator()(f32x4 (&acc)[2][2][4][2], const Unit& u, int wr, int wc, int fr, int fq) const {
        const int row0 = u.pm * BM + wr * 64 + fr, col0 = u.pn * BM + wc * 32 + 8 * fq;
        const int grp = u.pn >> 2; const float alpha = (grp == 0) ? 0.60653066f : (grp == 1) ? 1.0f : 0.0f, beta = (grp == 2) ? 1.0f : 0.0f;
        f32x4 bv[2][2];
#pragma unroll
        for (int bj = 0; bj < 2; ++bj)
#pragma unroll
            for (int n = 0; n < 2; ++n) bv[bj][n] = *(const f32x4*)(bias + col0 + bj * HALF + 4 * n);
#pragma unroll
        for (int ai = 0; ai < 2; ++ai)
#pragma unroll
            for (int m = 0; m < 4; ++m) { _Float16* rowp = O + (size_t)(row0 + ai * HALF + m * 16) * 3072 + col0;
#pragma unroll
                for (int bj = 0; bj < 2; ++bj) { f32x4 v0 = acc[ai][bj][m][0] + bv[bj][0], v1 = acc[ai][bj][m][1] + bv[bj][1];
#pragma unroll
                    for (int j = 0; j < 4; ++j) { v0[j] = alpha * __builtin_amdgcn_rcpf(1.0f + __expf(-v0[j])) + beta * v0[j]; v1[j] = alpha * __builtin_amdgcn_rcpf(1.0f + __expf(-v1[j])) + beta * v1[j]; }
                    u32x4 w; w.x = pk_f16(v0[0], v0[1]); w.y = pk_f16(v0[2], v0[3]); w.z = pk_f16(v1[0], v1[1]); w.w = pk_f16(v1[2], v1[3]);
                    *(u32x4*)(rowp + bj * HALF) = w; } }
    }
};

struct EpiResid {
    static constexpr bool PERM = false;
    const float* base; float* out; const float* gate;
    __device__ __forceinline__ void operator()(f32x4 (&acc)[2][2][4][2], const Unit& u, int wr, int wc, int fr, int fq) const {
        const int row0 = u.pm * BM + wr * 64 + fr, col0 = u.pn * BM + wc * 32 + 4 * fq;
        const float* gp = gate + ((u.pm * BM) >= SEQ ? ADA_N : 0) + col0;
        f32x4 gv[2][2];
#pragma unroll
        for (int bj = 0; bj < 2; ++bj)
#pragma unroll
            for (int n = 0; n < 2; ++n) gv[bj][n] = *(const f32x4*)(gp + bj * HALF + n * 16);
#pragma unroll
        for (int ai = 0; ai < 2; ++ai)
#pragma unroll
            for (int m = 0; m < 4; ++m) { const size_t off = (size_t)(row0 + ai * HALF + m * 16) * DM + col0;
#pragma unroll
                for (int bj = 0; bj < 2; ++bj)
#pragma unroll
                    for (int n = 0; n < 2; ++n) { const f32x4 bs = *(const f32x4*)(base + off + bj * HALF + n * 16);
                        *(f32x4*)(out + off + bj * HALF + n * 16) = bs + gv[bj][n] * acc[ai][bj][m][n]; } }
    }
};

struct PanelOrder {
    int c;
    __device__ __forceinline__ bool next(int i, Unit& u) const { if (i >= 4) return false; const int x = c & 7, l = c >> 3; u.pm = x * 16 + i * 4 + (l >> 3); u.pn = l & 7; return true; }
};
template <bool MID> struct EpiResidNorm {
    static constexpr bool PERM = false;
    const float* base; float* out; const float* gate; const float* gf; unsigned* xbuf; unsigned* cnt; PG8_LAS float* ls;
    bf16_t* hb; const float* adab;
    __device__ __forceinline__ void operator()(f32x4 (&acc)[2][2][4][2], const Unit& u, int wr, int wc, int fr, int fq) const {
        const int rl0 = wr * 64 + fr, col0 = u.pn * BM + wc * 32 + 4 * fq, tid = (wr * 4 + wc) * 64 + fq * 16 + fr;
        PG8_LAS float* P = ls; PG8_LAS float* S = ls + 1024;
        const float* gp = gate + ((u.pm * BM) >= SEQ ? ADA_N : 0) + col0;
        f32x4 gv[2][2];
#pragma unroll
        for (int bj = 0; bj < 2; ++bj)
#pragma unroll
            for (int n = 0; n < 2; ++n) gv[bj][n] = *(const f32x4*)(gp + bj * HALF + n * 16);
#pragma unroll
        for (int ai = 0; ai < 2; ++ai)
#pragma unroll
            for (int m = 0; m < 4; ++m) { const int rl = rl0 + ai * HALF + m * 16; const size_t off = (size_t)(u.pm * BM + rl) * DM + col0; float ss = 0.f;
#pragma unroll
                for (int bj = 0; bj < 2; ++bj)
#pragma unroll
                    for (int n = 0; n < 2; ++n) { const f32x4 bs = *(const f32x4*)(base + off + bj * HALF + n * 16); const f32x4 o = bs + gv[bj][n] * acc[ai][bj][m][n];
                        acc[ai][bj][m][n] = o; ss += (o.x * o.x + o.y * o.y) + (o.z * o.z + o.w * o.w); }
                ss += __shfl_xor(ss, 16); ss += __shfl_xor(ss, 32);
                if (fq == 0) P[rl * 4 + wc] = ss; }
        asm volatile("s_waitcnt lgkmcnt(0)" ::: "memory"); __builtin_amdgcn_s_barrier(); asm volatile("" ::: "memory");
        if (tid < 256) { const f32x4 p4 = *(const PG8_LAS f32x4*)(P + tid * 4);
            __hip_atomic_store(xbuf + (size_t)(u.pm * 8 + u.pn) * 256 + tid, __float_as_uint((p4.x + p4.y) + (p4.z + p4.w)), __ATOMIC_RELAXED, __HIP_MEMORY_SCOPE_AGENT); }
        asm volatile("s_waitcnt vmcnt(0)" ::: "memory"); __builtin_amdgcn_s_barrier(); asm volatile("" ::: "memory");
        if (tid == 0) {
            __builtin_amdgcn_fence(__ATOMIC_RELEASE, "agent"); asm volatile("s_waitcnt vmcnt(0)" ::: "memory");
            __hip_atomic_fetch_add(cnt + 64 * u.pm, 1u, __ATOMIC_RELAXED, __HIP_MEMORY_SCOPE_AGENT);
            unsigned sp = 0;
            while (__hip_atomic_load(cnt + 64 * u.pm, __ATOMIC_RELAXED, __HIP_MEMORY_SCOPE_AGENT) < 8u) { __builtin_amdgcn_s_sleep(2); if (++sp > (1u << 22)) break; }
            __builtin_amdgcn_fence(__ATOMIC_ACQUIRE, "agent"); asm volatile("s_waitcnt vmcnt(0)" ::: "memory");
        }
        asm volatile("s_waitcnt lgkmcnt(0)" ::: "memory"); __builtin_amdgcn_s_barrier(); asm volatile("" ::: "memory");
        if (tid < 256) { float sq = 0.f;
#pragma unroll
            for (int t = 0; t < 8; ++t) sq += __uint_as_float(__hip_atomic_load(xbuf + (size_t)(u.pm * 8 + t) * 256 + tid, __ATOMIC_RELAXED, __HIP_MEMORY_SCOPE_AGENT));
            S[tid] = __builtin_amdgcn_rsqf(sq * (1.0f / DM) + 1e-6f); }
        asm volatile("s_waitcnt lgkmcnt(0)" ::: "memory"); __builtin_amdgcn_s_barrier(); asm volatile("" ::: "memory");
        f32x4 fv[2][2], sv[2][2];
        const float* ab = adab + ((u.pm * BM) >= SEQ ? ADA_N : 0) + col0;
#pragma unroll
        for (int bj = 0; bj < 2; ++bj)
#pragma unroll
            for (int n = 0; n < 2; ++n) { fv[bj][n] = *(const f32x4*)(gf + col0 + bj * HALF + n * 16);
                if (MID) { fv[bj][n] = fv[bj][n] * (*(const f32x4*)(ab + 4 * DM + bj * HALF + n * 16) + 1.0f); sv[bj][n] = *(const f32x4*)(ab + 3 * DM + bj * HALF + n * 16); } }
#pragma unroll
        for (int ai = 0; ai < 2; ++ai)
#pragma unroll
            for (int m = 0; m < 4; ++m) { const int rl = rl0 + ai * HALF + m * 16; const size_t off = (size_t)(u.pm * BM + rl) * DM + col0; const float rs = S[rl];
#pragma unroll
                for (int bj = 0; bj < 2; ++bj)
#pragma unroll
                    for (int n = 0; n < 2; ++n) {
                        if (MID) { const f32x4 o = acc[ai][bj][m][n]; *(f32x4*)(out + off + bj * HALF + n * 16) = o;
                            const f32x4 y = (o * rs) * fv[bj][n] + sv[bj][n]; u32x2 w; w.x = cvt_pk_bf16(y.x, y.y); w.y = cvt_pk_bf16(y.z, y.w); *(u32x2*)(hb + off + bj * HALF + n * 16) = w; }
                        else *(f32x4*)(out + off + bj * HALF + n * 16) = (acc[ai][bj][m][n] * rs) * fv[bj][n]; } }
    }
};

struct EpiSwiglu {
    static constexpr bool PERM = true;
    bf16_t* O;
    __device__ __forceinline__ void operator()(f32x4 (&acc)[2][2][4][2], const Unit& u, int wr, int wc, int fr, int fq) const {
        const int row0 = u.pm * BM + wr * 64 + fr, col0 = u.pn * HALF + wc * 32 + 8 * fq;
#pragma unroll
        for (int ai = 0; ai < 2; ++ai)
#pragma unroll
            for (int m = 0; m < 4; ++m) {
                f32x4 h[2];
#pragma unroll
                for (int n = 0; n < 2; ++n) { const f32x4 gte = acc[ai][0][m][n], up = acc[ai][1][m][n];
#pragma unroll
                    for (int j = 0; j < 4; ++j) h[n][j] = gte[j] * __builtin_amdgcn_rcpf(1.0f + __expf(-gte[j])) * up[j]; }
                u32x4 w; w.x = cvt_pk_bf16(h[0][0], h[0][1]); w.y = cvt_pk_bf16(h[0][2], h[0][3]); w.z = cvt_pk_bf16(h[1][0], h[1][1]); w.w = cvt_pk_bf16(h[1][2], h[1][3]);
                *(u32x4*)(O + (size_t)(row0 + ai * HALF + m * 16) * FF + col0) = w;
            }
    }
};

template <class Epi, class Sched>
__device__ __forceinline__ void gemm_phase(PG8_LAS unsigned char* lds, const Gemm g, const Sched& S, const Epi& E, int wave_s) {
    const int tid = opaque_tid(wave_s), wid = __builtin_amdgcn_readfirstlane(tid >> 6), lane = tid & 63, wr = wid >> 2, wc = wid & 3, fr = lane & 15, fq = lane >> 4;
    const int K = g.K;
#define PG8_NT(un) ((g.kshort > 0 && ((un).pn >> 2) < 2) ? g.kshort / BK : K / BK)
    unsigned voffA[2], voffB[2];
#pragma unroll
    for (int i = 0; i < 2; ++i) { int R, C; stage_rc(tid * 16 + i * 8192, R, C); const int Rb = Epi::PERM ? ((R & ~31) + perm32(R & 31)) : R;
        voffA[i] = (unsigned)(R * g.lda + C) * 2u; voffB[i] = (unsigned)(Rb * g.ldb + C) * 2u; }
    const size_t kstep = (size_t)(BK * 2);
    const size_t hstepA = (size_t)HALF * g.lda * 2, hstepB = (size_t)HALF * g.ldb * 2;
    const size_t tstepA = 2 * hstepA, tstepB = 2 * hstepB;
    const unsigned ldsw = (unsigned)wid * 1024u;
    const int aoff = lds_byte(wr * 64 + fr, fq * 8), boff = lds_byte(wc * 32 + fr, fq * 8);
#define PG8_SA(b, h) (((b) * 2 + (h)) * HTB)
#define PG8_SB(b, h) ((4 + (b) * 2 + (h)) * HTB)
#define PG8_STAGE(bufoff, gbase, voff) do { _Pragma("unroll") for (int _i = 0; _i < 2; ++_i) \
        __builtin_amdgcn_global_load_lds((const unsigned*)((const char*)(gbase) + (voff)[_i]), (PG8_LAS unsigned*)(lds + (bufoff) + ldsw + _i * 8192), 16, 0, 0); } while (0)
#define PG8_LDA(dst, b, h) do { _Pragma("unroll") for (int m = 0; m < 4; ++m) _Pragma("unroll") for (int k = 0; k < 2; ++k) dst[m][k] = *(const PG8_LAS bf16x8*)(lds + PG8_SA(b, h) + aoff + m * 2048 + k * 1024); } while (0)
#define PG8_LDB(dst, b, h) do { _Pragma("unroll") for (int n = 0; n < 2; ++n) _Pragma("unroll") for (int k = 0; k < 2; ++k) dst[n][k] = *(const PG8_LAS bf16x8*)(lds + PG8_SB(b, h) + boff + n * 2048 + k * 1024); } while (0)
#define PG8_MMA(ai, bj, At, Bt) do { __builtin_amdgcn_s_setprio(1); _Pragma("unroll") for (int m = 0; m < 4; ++m) _Pragma("unroll") for (int n = 0; n < 2; ++n) _Pragma("unroll") for (int k = 0; k < 2; ++k) \
        acc[ai][bj][m][n] = __builtin_amdgcn_mfma_f32_16x16x32_bf16(Bt[n][k], At[m][k], acc[ai][bj][m][n], 0, 0, 0); __builtin_amdgcn_s_setprio(0); } while (0)
#define PG8_WAIT_V(n) asm volatile("s_waitcnt vmcnt(" #n ")" ::: "memory")
#define PG8_WAIT_L(n) asm volatile("s_waitcnt lgkmcnt(" #n ")" ::: "memory")
#define PG8_BAR __builtin_amdgcn_s_barrier()
#define PG8_SCHED __builtin_amdgcn_sched_barrier(0)
    Unit cur, nxt; int ui = 0;
    if (!S.next(0, cur)) return;
    int nt = PG8_NT(cur);
    f32x4 acc[2][2][4][2];
#pragma unroll
    for (int a = 0; a < 2; ++a)
#pragma unroll
        for (int b = 0; b < 2; ++b)
#pragma unroll
            for (int m = 0; m < 4; ++m)
#pragma unroll
                for (int n = 0; n < 2; ++n) acc[a][b][m][n] = (f32x4){0.f, 0.f, 0.f, 0.f};
    bf16x8 At[4][2], B0[2][2], B1[2][2];
    const char* cA = (const char*)g.A + (size_t)cur.pm * tstepA + (size_t)((cur.pn >> 2) * g.agrp) * 2; const char* cB = (const char*)g.Bt + (size_t)cur.pn * tstepB;
    PG8_STAGE(PG8_SB(0, 0), cB, voffB); PG8_STAGE(PG8_SB(0, 1), cB + hstepB, voffB); PG8_STAGE(PG8_SA(0, 0), cA, voffA); PG8_STAGE(PG8_SA(0, 1), cA + hstepA, voffA);
    if (wr == 1) PG8_BAR;
    PG8_WAIT_V(2); PG8_BAR;
    PG8_STAGE(PG8_SB(1, 0), cB + kstep, voffB); PG8_STAGE(PG8_SA(1, 0), cA + kstep, voffA); PG8_STAGE(PG8_SB(1, 1), cB + hstepB + kstep, voffB);
    PG8_WAIT_V(6); PG8_BAR;
    for (;;) {
        const bool has_next = S.next(ui + 1, nxt);
        const char* nA = has_next ? (const char*)g.A + (size_t)nxt.pm * tstepA + (size_t)((nxt.pn >> 2) * g.agrp) * 2 : cA; const char* nB = has_next ? (const char*)g.Bt + (size_t)nxt.pn * tstepB : cB;
        for (int t = 0; t < nt; t += 2) {
            const bool last = (t == nt - 2);
            const char* a1 = cA + (size_t)(t + 1) * kstep;
            const char* a2 = last ? nA : cA + (size_t)(t + 2) * kstep; const char* b2 = last ? nB : cB + (size_t)(t + 2) * kstep;
            const char* a3 = a2 + kstep; const char* b3 = b2 + kstep;
            PG8_LDB(B0, 0, 0); PG8_LDB(B1, 0, 1); PG8_SCHED; PG8_LDA(At, 0, 0); PG8_STAGE(PG8_SA(1, 1), a1 + hstepA, voffA);
            PG8_WAIT_V(8); PG8_WAIT_L(0); PG8_BAR; PG8_MMA(0, 0, At, B0); PG8_MMA(0, 1, At, B1); PG8_BAR; PG8_SCHED;
            PG8_LDA(At, 0, 1); PG8_STAGE(PG8_SB(0, 0), b2, voffB); PG8_STAGE(PG8_SB(0, 1), b2 + hstepB, voffB); PG8_STAGE(PG8_SA(0, 0), a2, voffA);
            PG8_WAIT_V(8); PG8_WAIT_L(0); PG8_BAR; PG8_MMA(1, 0, At, B0); PG8_MMA(1, 1, At, B1); PG8_BAR; PG8_SCHED;
            PG8_LDB(B0, 1, 0); PG8_LDB(B1, 1, 1); PG8_SCHED; PG8_LDA(At, 1, 0); PG8_STAGE(PG8_SA(0, 1), a2 + hstepA, voffA);
            PG8_WAIT_V(8); PG8_WAIT_L(0); PG8_BAR; PG8_MMA(0, 0, At, B0); PG8_MMA(0, 1, At, B1); PG8_BAR; PG8_SCHED;
            PG8_LDA(At, 1, 1); PG8_STAGE(PG8_SB(1, 0), b3, voffB); PG8_STAGE(PG8_SB(1, 1), b3 + hstepB, voffB); PG8_STAGE(PG8_SA(1, 0), a3, voffA);
            PG8_WAIT_V(8); PG8_WAIT_L(0); PG8_BAR; PG8_MMA(1, 0, At, B0); PG8_MMA(1, 1, At, B1); PG8_BAR; PG8_SCHED;
        }
        if (wr == 0) PG8_BAR;
        E(acc, cur, wr, wc, fr, fq);
        if (!has_next) break;
#pragma unroll
        for (int a = 0; a < 2; ++a)
#pragma unroll
            for (int b = 0; b < 2; ++b)
#pragma unroll
                for (int m = 0; m < 4; ++m)
#pragma unroll
                    for (int n = 0; n < 2; ++n) acc[a][b][m][n] = (f32x4){0.f, 0.f, 0.f, 0.f};
        cur = nxt; cA = nA; cB = nB; ++ui; nt = PG8_NT(cur);
        if (wr == 1) PG8_BAR;
    }
    PG8_WAIT_V(0);
    PG8_BAR;
#undef PG8_NT
#undef PG8_SA
#undef PG8_SB
#undef PG8_STAGE
#undef PG8_LDA
#undef PG8_LDB
#undef PG8_MMA
#undef PG8_WAIT_V
#undef PG8_WAIT_L
#undef PG8_BAR
#undef PG8_SCHED
}
}

struct Args { const void* in[24]; float* out; unsigned char* ws; int ph_lo, ph_hi; };
enum { I_X = 0, I_C, I_POS, I_WADA, I_BADA, I_N1G, I_N2G, I_NFG, I_WIN, I_WOUT, I_MU, I_W0, I_WDEC, I_A0, I_WICLR, I_WGATE, I_KK, I_KA, I_RK, I_GNG, I_GNB, I_FG, I_FU, I_FD };

__device__ __forceinline__ void transpose_item(const float* W, int Ksrc, int N, bf16_t* WT, int ldk, int drow0, int k0, int n0, LAS float* scr, int lane) {
    float tv[32];
#pragma unroll
    for (int i = 0; i < 32; ++i) { const int k = k0 + 2 * i + (lane >> 5); tv[i] = (k < Ksrc) ? W[(size_t)k * N + n0 + (lane & 31)] : 0.f; }
#pragma unroll
    for (int i = 0; i < 32; ++i) scr[(2 * i + (lane >> 5)) * 33 + (lane & 31)] = tv[i];
    LDS_WAIT();
    const int c = lane & 7;
#pragma unroll
    for (int j = 0; j < 4; ++j) { const int n = (lane >> 3) + 8 * j; const LAS float* s = scr + (8 * c) * 33 + n;
        u32x4 o; o.x = pk2(s[0 * 33], s[1 * 33]); o.y = pk2(s[2 * 33], s[3 * 33]); o.z = pk2(s[4 * 33], s[5 * 33]); o.w = pk2(s[6 * 33], s[7 * 33]);
        *(u32x4*)(WT + (size_t)(drow0 + n) * ldk + k0 + 8 * c) = o; }
    LDS_WAIT();
}

__device__ __forceinline__ void norm_rows_mod(const float* X, bf16_t* H, const float* gvec, const float* sc, const float* sh, int gw, int NGW, int lane) {
    for (int row = gw; row < T; row += NGW) {
        const int bo = (row >= SEQ) ? ADA_N : 0;
        const f32x4* xr = (const f32x4*)(X + (size_t)row * DM) + lane;
        f32x4 v[8]; float ss = 0.f;
#pragma unroll
        for (int j = 0; j < 8; ++j) { v[j] = xr[64 * j]; ss += (v[j].x * v[j].x + v[j].y * v[j].y) + (v[j].z * v[j].z + v[j].w * v[j].w); }
        const float rstd = 1.0f / sqrtf(wave_sum(ss) * (1.0f / DM) + 1e-6f);
        u32x2* o8 = (u32x2*)(H + (size_t)row * DM) + lane;
#pragma unroll
        for (int j = 0; j < 8; ++j) { const int col = 4 * lane + 256 * j;
            const f32x4 g4 = *(const f32x4*)(gvec + col), s4 = *(const f32x4*)(sc + bo + col), h4 = *(const f32x4*)(sh + bo + col);
            const f32x4 y = (v[j] * rstd) * g4 * (s4 + 1.0f) + h4;
            u32x2 w; w.x = pk2(y.x, y.y); w.y = pk2(y.z, y.w); o8[64 * j] = w; }
    }
}

struct ScanPtrs {
    const bf16_t* proj; const _Float16* lz; const float* kkn;
    const float *mu, *k_k, *k_a, *r_k, *gn_g, *gn_b;
    float* cs; float* sinit; bf16_t* mix;
};
template <int MODE, int TS>
__device__ __forceinline__ void scan_item(LAS float* W, const ScanPtrs& p, int chain, int c, int lane) {
    const int b = chain >> 4, h = chain & 15, hc = h * 64 + lane, rg = lane >> 2, cgi = lane & 3;
    f32x2 su[4][8];
    if (MODE == 2 && c > 0) {
#pragma unroll
        for (int r = 0; r < 4; ++r) { const f32x4* sp = (const f32x4*)(p.sinit + ((size_t)(chain * NCH + c) * 4096 + (4 * rg + r) * 64 + 16 * cgi));
#pragma unroll
            for (int i = 0; i < 4; ++i) { const f32x4 t = sp[i]; su[r][2 * i] = t.xy; su[r][2 * i + 1] = t.zw; } }
    } else {
#pragma unroll
        for (int r = 0; r < 4; ++r)
#pragma unroll
            for (int cc = 0; cc < 8; ++cc) su[r][cc] = (MODE == 1) ? (f32x2){(4 * rg + r == 16 * cgi + 2 * cc) ? 1.f : 0.f, (4 * rg + r == 16 * cgi + 2 * cc + 1) ? 1.f : 0.f} : (f32x2){0.f, 0.f};
    }
    const float mu_r = p.mu[hc], mu_k = p.mu[1024 + hc], mu_v = p.mu[2048 + hc], kkc = p.k_k[hc], kac = p.k_a[hc];
    float rkc = 0.f, gng = 0.f, gnb = 0.f;
    if (MODE == 2) { rkc = p.r_k[hc]; gng = p.gn_g[hc]; gnb = p.gn_b[hc]; }
    const int t0 = c * CL; const size_t row0 = (size_t)b * SEQ + t0;
    float rp = 0.f, kp = 0.f, vp = 0.f;
    if (t0 > 0) { const bf16_t* pr = p.proj + (row0 - 1) * LDP; rp = bf2f(pr[PC_R + hc]); kp = bf2f(pr[PC_RK + hc]); vp = bf2f(pr[PC_RV + hc]); }
    bf16_t qr[TS], qk[TS], qv[TS]; _Float16 qz[TS], qa[TS], qg[TS]; float qn[TS];
#define SCAN_LOAD(sc_) do { _Pragma("unroll") for (int st = 0; st < TS; ++st) { const size_t row = row0 + (sc_) * TS + st; const bf16_t* pr = p.proj + row * LDP; const _Float16* lzr = p.lz + row * 3072 + hc; \
        if (MODE != 1) { qr[st] = pr[PC_R + hc]; qv[st] = pr[PC_RV + hc]; } qk[st] = pr[PC_RK + hc]; qz[st] = lzr[0]; qa[st] = lzr[1024]; if (MODE == 2) qg[st] = lzr[2048]; qn[st] = p.kkn[row * 16 + h]; } } while (0)
    SCAN_LOAD(0);
#pragma unroll 1
    for (int sc = 0; sc < CL / TS; ++sc) {
#pragma unroll
        for (int st = 0; st < TS; ++st) {
            const float kc = bf2f(qk[st]);
            const float k = kc + (kp - kc) * mu_k; kp = kc;
            const float av = (float)qa[st], inv = qn[st];
            const float dec = __expf(-(float)qz[st]);
            const float kk = k * kkc * inv;
            LAS float* V = W + st * 512;
            V[lane] = -kk; V[64 + lane] = dec; V[128 + lane] = kk * av;
            if (MODE != 1) {
                const float rc = bf2f(qr[st]), vc = bf2f(qv[st]);
                const float r = rc + (rp - rc) * mu_r, v = vc + (vp - vc) * mu_v; rp = rc; vp = vc;
                const float kpr = k * (1.0f + (av - 1.0f) * kac);
                V[192 + lane] = kpr; V[320 + lane] = v;
                if (MODE == 2) { V[256 + lane] = r; V[384 + lane] = (float)qg[st]; }
            }
        }
        if (sc + 1 < CL / TS) SCAN_LOAD(sc + 1);
#pragma unroll (MODE == 2 ? 2 : 4)
        for (int st = 0; st < TS; ++st) {
            const LAS float* V = W + st * 512;
            const LAS f32x4* Nq = (const LAS f32x4*)(V + 16 * cgi);
            const LAS f32x4* Dq = (const LAS f32x4*)(V + 64 + 16 * cgi); const LAS f32x4* Bq = (const LAS f32x4*)(V + 128 + 16 * cgi); const LAS f32x4* Kq = (const LAS f32x4*)(V + 192 + 16 * cgi);
            const LAS f32x4* Rq = (const LAS f32x4*)(V + 256 + 16 * cgi);
            f32x4 n4[4], d4[4], b4[4], k4[4], r4[4], v4 = {0.f, 0.f, 0.f, 0.f};
#pragma unroll
            for (int i = 0; i < 4; ++i) n4[i] = Nq[i];
#pragma unroll
            for (int i = 0; i < 4; ++i) { d4[i] = Dq[i]; b4[i] = Bq[i]; if (MODE != 1) k4[i] = Kq[i]; if (MODE == 2) r4[i] = Rq[i]; }
            if (MODE != 1) v4 = *(const LAS f32x4*)(V + 320 + 4 * rg);
            f32x2 au[4];
#pragma unroll
            for (int r = 0; r < 4; ++r) au[r] = (f32x2){0.f, 0.f};
#pragma unroll
            for (int i = 0; i < 4; ++i)
#pragma unroll
                for (int r = 0; r < 4; ++r) { au[r] += su[r][2 * i] * n4[i].xy; au[r] += su[r][2 * i + 1] * n4[i].zw; }
            float sau[4];
#pragma unroll
            for (int r = 0; r < 4; ++r) { float t = au[r].x + au[r].y; t += dpp_mov<0xB1>(t); t += dpp_mov<0x4E>(t); sau[r] = t; }
            f32x2 ao[4];
#pragma unroll
            for (int r = 0; r < 4; ++r) ao[r] = (f32x2){0.f, 0.f};
#pragma unroll
            for (int i = 0; i < 4; ++i) {
#pragma unroll
                for (int r = 0; r < 4; ++r) {
                    if (MODE == 1) { su[r][2 * i] = su[r][2 * i] * d4[i].xy + b4[i].xy * sau[r]; su[r][2 * i + 1] = su[r][2 * i + 1] * d4[i].zw + b4[i].zw * sau[r]; }
                    else { su[r][2 * i] = su[r][2 * i] * d4[i].xy + b4[i].xy * sau[r] + k4[i].xy * v4[r]; su[r][2 * i + 1] = su[r][2 * i + 1] * d4[i].zw + b4[i].zw * sau[r] + k4[i].zw * v4[r]; }
                    if (MODE == 2) { ao[r] += su[r][2 * i] * r4[i].xy; ao[r] += su[r][2 * i + 1] * r4[i].zw; }
                }
            }
            if (MODE == 2) {
                float o[4];
#pragma unroll
                for (int r = 0; r < 4; ++r) { float t = ao[r].x + ao[r].y; t += dpp_mov<0xB1>(t); t += dpp_mov<0x4E>(t); o[r] = t; }
                const float osel = (cgi == 0) ? o[0] : (cgi == 1) ? o[1] : (cgi == 2) ? o[2] : o[3];
                W[st * 512 + 128 + lane] = osel;
            }
        }
        if (MODE == 2) {
            const int pst = lane >> 3, pc = (lane & 7) * 8;
            const LAS float* V = W + pst * 512;
            const f32x4 x0 = *(const LAS f32x4*)(V + 128 + pc), x1 = *(const LAS f32x4*)(V + 128 + pc + 4);
            float sm = ((x0.x + x0.y) + (x0.z + x0.w)) + ((x1.x + x1.y) + (x1.z + x1.w));
            sm += dpp_mov<0xB1>(sm); sm += dpp_mov<0x4E>(sm); sm += dpp_mov<0x141>(sm);
            const float mean = sm * (1.0f / 64.0f);
            const f32x4 d0 = x0 - mean, d1 = x1 - mean;
            float sq = ((d0.x * d0.x + d0.y * d0.y) + (d0.z * d0.z + d0.w * d0.w)) + ((d1.x * d1.x + d1.y * d1.y) + (d1.z * d1.z + d1.w * d1.w));
            sq += dpp_mov<0xB1>(sq); sq += dpp_mov<0x4E>(sq); sq += dpp_mov<0x141>(sq);
            const float rstd = __builtin_amdgcn_rsqf(sq * (1.0f / 64.0f) + 64e-5f);
            const f32x4 g0 = *(const f32x4*)(p.gn_g + h * 64 + pc), g1 = *(const f32x4*)(p.gn_g + h * 64 + pc + 4), b0 = *(const f32x4*)(p.gn_b + h * 64 + pc), b1 = *(const f32x4*)(p.gn_b + h * 64 + pc + 4);
            const f32x4 v0 = *(const LAS f32x4*)(V + 320 + pc), v1 = *(const LAS f32x4*)(V + 320 + pc + 4), q0 = *(const LAS f32x4*)(V + 384 + pc), q1 = *(const LAS f32x4*)(V + 384 + pc + 4);
            const f32x4 r0 = *(const LAS f32x4*)(V + 256 + pc), r1 = *(const LAS f32x4*)(V + 256 + pc + 4), k0_ = *(const LAS f32x4*)(V + 192 + pc), k1_ = *(const LAS f32x4*)(V + 192 + pc + 4);
            const f32x4 c0 = *(const f32x4*)(p.r_k + h * 64 + pc), c1 = *(const f32x4*)(p.r_k + h * 64 + pc + 4);
            const f32x4 t0 = r0 * k0_ * c0, t1 = r1 * k1_ * c1;
            float rk = ((t0.x + t0.y) + (t0.z + t0.w)) + ((t1.x + t1.y) + (t1.z + t1.w));
            rk += dpp_mov<0xB1>(rk); rk += dpp_mov<0x4E>(rk); rk += dpp_mov<0x141>(rk);
            const f32x4 y0 = ((d0 * rstd) * g0 + b0 + v0 * rk) * q0, y1 = ((d1 * rstd) * g1 + b1 + v1 * rk) * q1;
            u32x4 wv; wv.x = pk2hw(y0.x, y0.y); wv.y = pk2hw(y0.z, y0.w); wv.z = pk2hw(y1.x, y1.y); wv.w = pk2hw(y1.z, y1.w);
            const size_t row = row0 + sc * TS + pst;
            *(u32x4*)(p.mix + row * DM + 1024 + h * 64 + pc) = wv;
        }
    }
#undef SCAN_LOAD
    if (MODE != 2) {
#pragma unroll
        for (int r = 0; r < 4; ++r) {
            f32x4* du = (f32x4*)(p.cs + ((size_t)((chain * NCH + c) * 2 + MODE) * 4096 + (4 * rg + r) * 64 + 16 * cgi));
#pragma unroll
            for (int i = 0; i < 4; ++i) du[i] = (f32x4){su[r][2 * i].x, su[r][2 * i].y, su[r][2 * i + 1].x, su[r][2 * i + 1].y};
        }
    }
}

__device__ __forceinline__ void scan_combine(LAS float* L, const float* cs, float* sinit, int chain, int tid) {
#define SC_LDS_BARRIER() do { asm volatile("s_waitcnt lgkmcnt(0)" ::: "memory"); __builtin_amdgcn_s_barrier(); asm volatile("" ::: "memory"); } while (0)
    LAS float* Sl = L; LAS float* Pl = L + 64 * 68;
    const int i = tid & 63, w8 = __builtin_amdgcn_readfirstlane(tid >> 6);
    const float* base = cs + (size_t)(chain * NCH) * 2 * 4096;
    f32x4 pP0 = *(const f32x4*)(base + 4096 + tid * 8), pP1 = *(const f32x4*)(base + 4096 + tid * 8 + 4);
    f32x4 pU0 = *(const f32x4*)(base + i * 64 + 8 * w8), pU1 = *(const f32x4*)(base + i * 64 + 8 * w8 + 4);
    f32x4 a0 = {0.f, 0.f, 0.f, 0.f}, a1 = {0.f, 0.f, 0.f, 0.f};
#pragma unroll 1
    for (int c = 0; c < NCH - 1; ++c) {
        *(LAS f32x4*)(Sl + i * 68 + 8 * w8) = a0; *(LAS f32x4*)(Sl + i * 68 + 8 * w8 + 4) = a1;
        *(LAS f32x4*)(Pl + tid * 8) = pP0; *(LAS f32x4*)(Pl + tid * 8 + 4) = pP1;
        f32x4 u0 = pU0, u1 = pU1;
        SC_LDS_BARRIER();
        if (c + 1 < NCH - 1) { const float* nb = base + (size_t)(c + 1) * 2 * 4096;
            pP0 = *(const f32x4*)(nb + 4096 + tid * 8); pP1 = *(const f32x4*)(nb + 4096 + tid * 8 + 4);
            pU0 = *(const f32x4*)(nb + i * 64 + 8 * w8); pU1 = *(const f32x4*)(nb + i * 64 + 8 * w8 + 4); }
        f32x4 srow[16];
#pragma unroll
        for (int k = 0; k < 16; ++k) srow[k] = *(const LAS f32x4*)(Sl + i * 68 + 4 * k);
#pragma unroll
        for (int j = 0; j < 64; ++j) { const float sij = srow[j >> 2][j & 3];
            const f32x4 p0 = *(const LAS f32x4*)(Pl + j * 64 + 8 * w8), p1 = *(const LAS f32x4*)(Pl + j * 64 + 8 * w8 + 4); u0 += p0 * sij; u1 += p1 * sij; }
        a0 = u0; a1 = u1;
        SC_LDS_BARRIER();
        float* so = sinit + (size_t)(chain * NCH + c + 1) * 4096 + i * 64 + 8 * w8;
        *(f32x4*)so = a0; *(f32x4*)(so + 4) = a1;
    }
#undef SC_LDS_BARRIER
}

constexpr int KS_STRIDE = 72, VT_STRIDE = 288;
constexpr int ATT_KS_OFF = 0, ATT_VT_OFF = 256 * KS_STRIDE * 2;
constexpr int ATT_UNITS = 12288;
struct AttnUnit { int b, h, g, dl, res, n, u; };
__device__ __forceinline__ AttnUnit attn_decode(int u) {
    AttnUnit a; a.u = u; const int bh = u / 384, rest = u % 384; a.g = rest / 128; const int rn = rest % 128;
    a.b = bh >> 4; a.h = bh & 15; a.dl = (a.g == 0) ? 1 : (a.g == 1 ? 4 : 16);
    const int nbk = 128 / a.dl; a.res = rn / nbk; a.n = rn % nbk; return a;
}
__device__ __forceinline__ void attn_load(const AttnUnit& a, const bf16_t* proj, int tid, u32x4 (&kv)[4], u32x4 (&vv)[4]) {
#pragma unroll
    for (int ps = 0; ps < 4; ++ps) {
        const int idx = ps * 512 + tid, key = idx >> 3, seg = idx & 7;
        const int sub = (a.n - 1) * 128 + key, subc = sub < 0 ? 0 : sub;
        const size_t row = (size_t)a.b * SEQ + (size_t)subc * a.dl + a.res; const bf16_t* pr = proj + row * LDP + a.h * 64 + seg * 8;
        kv[ps] = *(const u32x4*)(pr + PC_K); vv[ps] = *(const u32x4*)(pr + PC_V);
    }
}
__device__ __forceinline__ void attn_stage(LAS unsigned char* lds, int tid, int n, const u32x4 (&kv)[4], const u32x4 (&vv)[4]) {
    LAS bf16_t* Ks = (LAS bf16_t*)(lds + ATT_KS_OFF);
    LAS bf16_t* Vt = (LAS bf16_t*)(lds + ATT_VT_OFF);
#pragma unroll
    for (int ps = 0; ps < 4; ++ps) {
        const int idx = ps * 512 + tid, key = idx >> 3, seg = idx & 7;
        u32x4 k4 = kv[ps], v4 = vv[ps];
        if (n == 0 && ps < 2) { k4 = (u32x4){0u, 0u, 0u, 0u}; v4 = (u32x4){0u, 0u, 0u, 0u}; }
        *(LAS u32x4*)(Ks + key * KS_STRIDE + seg * 8) = k4;
        LAS bf16_t* vd = Vt + (seg * 8) * VT_STRIDE + (key ^ (seg << 2));
        vd[0 * VT_STRIDE] = (bf16_t)(v4.x & 0xffffu); vd[1 * VT_STRIDE] = (bf16_t)(v4.x >> 16);
        vd[2 * VT_STRIDE] = (bf16_t)(v4.y & 0xffffu); vd[3 * VT_STRIDE] = (bf16_t)(v4.y >> 16);
        vd[4 * VT_STRIDE] = (bf16_t)(v4.z & 0xffffu); vd[5 * VT_STRIDE] = (bf16_t)(v4.z >> 16);
        vd[6 * VT_STRIDE] = (bf16_t)(v4.w & 0xffffu); vd[7 * VT_STRIDE] = (bf16_t)(v4.w >> 16);
    }
}
struct AttnOut { unsigned c01[4], c23[4]; float lsev; };
__device__ __forceinline__ void attn_compute(LAS unsigned char* lds, const AttnUnit& a, const bf16x8 (&qf)[2], AttnOut& o, int tid) {
    const int lane = tid & 63, w = __builtin_amdgcn_readfirstlane(tid >> 6), r = lane & 15, q = lane >> 4;
    const int n = a.n, dl = a.dl, res = a.res, b = a.b, h = a.h, g = a.g;
    const LAS bf16_t* Ks = (const LAS bf16_t*)(lds + ATT_KS_OFF);
    const LAS bf16_t* Vt = (const LAS bf16_t*)(lds + ATT_VT_OFF);
    f32x4 sacc[9];
#pragma unroll
    for (int kt = 0; kt < 9; ++kt) {
        sacc[kt] = (f32x4){0.f, 0.f, 0.f, 0.f};
#pragma unroll
        for (int ks = 0; ks < 2; ++ks) {
            const bf16x8 kf = *(const LAS bf16x8*)(Ks + (16 * w + 16 * kt + r) * KS_STRIDE + 32 * ks + 8 * q);
            sacc[kt] = __builtin_amdgcn_mfma_f32_16x16x32_bf16(kf, qf[ks], sacc[kt], 0, 0, 0);
        }
    }
    float mx = -INFINITY;
#pragma unroll
    for (int j = 0; j < 4; ++j) { if (4 * q + j < r) sacc[0][j] = -INFINITY; if (4 * q + j > r) sacc[8][j] = -INFINITY; }
    if (n == 0) {
#pragma unroll
        for (int kt = 0; kt < 8; ++kt)
#pragma unroll
            for (int j = 0; j < 4; ++j) if (16 * w + 16 * kt + 4 * q + j < 128) sacc[kt][j] = -INFINITY;
    }
#pragma unroll
    for (int kt = 0; kt < 9; ++kt)
#pragma unroll
        for (int j = 0; j < 4; ++j) mx = fmaxf(mx, sacc[kt][j]);
    mx = fmaxf(mx, __shfl_xor(mx, 16)); mx = fmaxf(mx, __shfl_xor(mx, 32));
    float lsum = 0.f;
    const float mxl = mx * 1.44269504f;
#pragma unroll
    for (int kt = 0; kt < 9; ++kt)
#pragma unroll
        for (int j = 0; j < 4; ++j) { const float pv = __builtin_amdgcn_exp2f(__builtin_fmaf(sacc[kt][j], 1.44269504f, -mxl)); sacc[kt][j] = pv; lsum += pv; }
    lsum += __shfl_xor(lsum, 16); lsum += __shfl_xor(lsum, 32);
    const LAS bf16_t* vlo[4]; const LAS bf16_t* vhi[4];
#pragma unroll
    for (int dt = 0; dt < 4; ++dt) { const int d = 16 * dt + r, sw = (d >> 3) << 2, kb = 16 * w + 4 * q;
        vlo[dt] = Vt + d * VT_STRIDE + (kb ^ sw); vhi[dt] = Vt + d * VT_STRIDE + ((kb + 16) ^ sw); }
    f32x4 oacc[4];
#pragma unroll
    for (int dt = 0; dt < 4; ++dt) oacc[dt] = (f32x4){0.f, 0.f, 0.f, 0.f};
#pragma unroll
    for (int kp = 0; kp < 5; ++kp) {
        u32x4 pw;
        pw.x = pk2hw(sacc[2 * kp][0], sacc[2 * kp][1]); pw.y = pk2hw(sacc[2 * kp][2], sacc[2 * kp][3]);
        if (kp < 4) { pw.z = pk2hw(sacc[2 * kp + 1][0], sacc[2 * kp + 1][1]); pw.w = pk2hw(sacc[2 * kp + 1][2], sacc[2 * kp + 1][3]); } else { pw.z = 0u; pw.w = 0u; }
        const bf16x8 pf = __builtin_bit_cast(bf16x8, pw);
#pragma unroll
        for (int dt = 0; dt < 4; ++dt) {
            const s16x4 lo = *(const LAS s16x4*)(vlo[dt] + 32 * kp), hi = *(const LAS s16x4*)(vhi[dt] + 32 * kp);
            const bf16x8 vf = __builtin_shufflevector(lo, hi, 0, 1, 2, 3, 4, 5, 6, 7);
            oacc[dt] = __builtin_amdgcn_mfma_f32_16x16x32_bf16(pf, vf, oacc[dt], 0, 0, 0);
        }
    }
    const float linv = __builtin_amdgcn_rcpf(lsum);
#pragma unroll
    for (int j = 0; j < 4; ++j) {
        const float li = __shfl(linv, 4 * q + j);
        o.c01[j] = pk2hw(oacc[0][j] * li, oacc[1][j] * li); o.c23[j] = pk2hw(oacc[2][j] * li, oacc[3][j] * li);
    }
    o.lsev = mx + __logf(lsum);
}
__device__ __forceinline__ void attn_store(const AttnUnit& a, const AttnOut& o, bf16_t* op01, bf16_t* op2, float* lse, int tid) {
    const int lane = tid & 63, w = __builtin_amdgcn_readfirstlane(tid >> 6), r = lane & 15, q = lane >> 4;
    bf16_t* ob = (a.g == 2) ? op2 : (op01 + (size_t)a.g * T * 1024);
#pragma unroll
    for (int j = 0; j < 4; ++j) {
        const int qs2 = a.n * 128 + 16 * w + 4 * q + j;
        const size_t orow = (size_t)a.b * SEQ + (size_t)qs2 * a.dl + a.res;
        bf16_t* op_ = ob + orow * 1024 + a.h * 64 + r;
        op_[0] = (bf16_t)(o.c01[j] & 0xffffu); op_[16] = (bf16_t)(o.c01[j] >> 16); op_[32] = (bf16_t)(o.c23[j] & 0xffffu); op_[48] = (bf16_t)(o.c23[j] >> 16);
    }
    if (q == 0) lse[(size_t)a.u * 128 + 16 * w + r] = o.lsev;
}
__device__ __forceinline__ void attn_phase(LAS unsigned char* lds, int ubeg, int ustride, int ucnt, const bf16_t* proj, bf16_t* op01, bf16_t* op2, float* lse, int tid) {
#define ATT_LDS_BARRIER() do { asm volatile("s_waitcnt lgkmcnt(0)" ::: "memory"); __builtin_amdgcn_s_barrier(); asm volatile("" ::: "memory"); } while (0)
    LAS bf16_t* Vt = (LAS bf16_t*)(lds + ATT_VT_OFF);
    const int lane = tid & 63, w = __builtin_amdgcn_readfirstlane(tid >> 6), r = lane & 15, q = lane >> 4;
    for (int idx = tid; idx < 64 * 16; idx += 512) { const int d = idx >> 4, cc = idx & 15; *(LAS unsigned*)(Vt + d * VT_STRIDE + 256 + 2 * cc) = 0u; }
    __syncthreads();
    if (ucnt <= 0) return;
    u32x4 kv[4], vv[4]; bf16x8 qn[2];
#define ATT_LOADQ(dst, au) do { const size_t qrow_ = (size_t)(au).b * SEQ + (size_t)((au).n * 128 + 16 * w + r) * (au).dl + (au).res; \
        dst[0] = *(const bf16x8*)(proj + qrow_ * LDP + PC_Q + (au).h * 64 + 8 * q); dst[1] = *(const bf16x8*)(proj + qrow_ * LDP + PC_Q + (au).h * 64 + 32 + 8 * q); } while (0)
    { const AttnUnit a0 = attn_decode(ubeg); ATT_LOADQ(qn, a0); attn_load(a0, proj, tid, kv, vv); }
    AttnOut o;
#pragma unroll
    for (int j = 0; j < 4; ++j) { o.c01[j] = 0u; o.c23[j] = 0u; }
    o.lsev = 0.f;
    for (int i = 0; i < ucnt; ++i) {
        const AttnUnit a0 = attn_decode(ubeg + i * ustride);
        attn_stage(lds, tid, a0.n, kv, vv);
        if (i > 0) { const AttnUnit ap = attn_decode(ubeg + (i - 1) * ustride); attn_store(ap, o, op01, op2, lse, tid); }
        bf16x8 qf[2]; qf[0] = qn[0]; qf[1] = qn[1];
        { const int inext = (i + 1 < ucnt) ? i + 1 : i; const AttnUnit a1 = attn_decode(ubeg + inext * ustride); ATT_LOADQ(qn, a1); attn_load(a1, proj, tid, kv, vv); }
        ATT_LDS_BARRIER();
        attn_compute(lds, a0, qf, o, tid);
        ATT_LDS_BARRIER();
    }
    { const AttnUnit ap = attn_decode(ubeg + (ucnt - 1) * ustride); attn_store(ap, o, op01, op2, lse, tid); }
#undef ATT_LDS_BARRIER
#undef ATT_LOADQ
    __syncthreads();
}

__global__ void __launch_bounds__(512, 2) mk_fwd(Args a) {
    extern __shared__ __attribute__((aligned(16))) unsigned char lds_raw[];
    cg::grid_group grid = cg::this_grid();
    LAS unsigned char* lds = (LAS unsigned char*)lds_raw;
    const int G = gridDim.x, bx = blockIdx.x;
    const int NGW = G * 8, NGT = G * 512;
#define PH_IDS const int tid = opaque_tid(wave_s), lane = tid & 63, wave = wave_s, gw = bx * 8 + wave, gt = bx * 512 + tid; (void)lane; (void)gw; (void)gt; (void)wave; PH_WS
#define PH_WS __attribute__((address_space(1))) unsigned char* ws = (__attribute__((address_space(1))) unsigned char*)a.ws; asm volatile("" : "+s"(ws)); float* const outp = a.out
#define ctl ((unsigned*)(ws + WS_CTL))
#define x_in ((const float*)a.in[I_X])
#define adap ((float*)(ws + WS_ADAP))
#define ada ((float*)(ws + WS_ADA))
#define rope ((float*)(ws + WS_ROPE))
#define kkn ((float*)(ws + WS_KKN))
#define lse ((float*)(ws + WS_LSE))
#define WdT ((bf16_t*)(ws + WS_WLORA))
#define WaT (WdT + 1024 * 256)
#define WgT (WdT + 2 * 1024 * 256)
#define WinT ((bf16_t*)(ws + WS_WIN))
#define WoutT ((bf16_t*)(ws + WS_WOUT))
#define WguT ((bf16_t*)(ws + WS_WGU))
#define WdownT ((bf16_t*)(ws + WS_WDOWN))
#define lact ((bf16_t*)(ws + WS_LACT))
#define cs ((float*)(ws + WS_CS))
#define sinit ((float*)(ws + WS_SINIT))
#define proj ((bf16_t*)(ws + WS_PROJ))
#define hid ((bf16_t*)(ws + WS_PROJ))
#define hbuf ((bf16_t*)(ws + WS_HBUF))
#define mix ((bf16_t*)(ws + WS_MIX))
#define op2 ((bf16_t*)(ws + WS_OP2))
#define lz ((_Float16*)outp)
#define lbias ((float*)(ws + WS_ADA + 512 * 1024))
#define IN(k) (a.ph_lo <= (k) && (k) < a.ph_hi)
#ifndef MK_PROBE
#define MK_PROBE -1
#endif
#define REPS(k) for (int rep_ = 0; rep_ < ((MK_PROBE == (k)) ? 2 : 1); ++rep_)
    volatile LAS unsigned* bst = (volatile LAS unsigned*)(lds + 140032);
    const int wave_s = __builtin_amdgcn_readfirstlane((int)threadIdx.x >> 6);
    if (threadIdx.x == 0) { bst[0] = 0u; bst[1] = 0u; }
    __syncthreads();
    XcdBarrier xbar; xbar.bar = (unsigned*)(a.ws + WS_CTL) + 4096; xbar.x = 0; xbar.st = bst;
    if (a.ph_hi - a.ph_lo > 1) xbar = xcd_barrier_post((unsigned*)(a.ws + WS_CTL) + 4096, bst, threadIdx.x == 0);
#define SYNC(k) do { if (IN(k) && IN((k) + 1)) { if ((k) == 0) grid.sync(); else xcd_barrier(xbar, wave_s); } } while (0)

    if (IN(0)) {
        PH_IDS;
        LAS float* scr = (LAS float*)(lds + wave * 16384);
        constexpr int I_IN = 32 * 201, I_OUT = 32 * 64, I_G = 32 * 176, I_D = 88 * 64, I_LD = 4 * 32, I_LG = 4 * 32;
        constexpr int NITEMS = I_IN + I_OUT + 2 * I_G + I_D + 2 * I_LD + I_LG;
        for (int it = gw; it < NITEMS; it += NGW) {
            int r_ = it;
            if (r_ < I_IN) { const int kb = r_ / 201, nb = r_ % 201; transpose_item((const float*)a.in[I_WIN], DM, NPROJ, WinT, DM, 32 * nb, 64 * kb, 32 * nb, scr, lane); continue; } r_ -= I_IN;
            if (r_ < I_OUT) { const int kb = r_ / 64, nb = r_ % 64; transpose_item((const float*)a.in[I_WOUT], DM, DM, WoutT, DM, 32 * nb, 64 * kb, 32 * nb, scr, lane); continue; } r_ -= I_OUT;
            if (r_ < I_G) { const int kb = r_ / 176, nb = r_ % 176, n0 = 32 * nb; transpose_item((const float*)a.in[I_FG], DM, FF, WguT, DM, 256 * (n0 / 128) + (n0 % 128), 64 * kb, n0, scr, lane); continue; } r_ -= I_G;
            if (r_ < I_G) { const int kb = r_ / 176, nb = r_ % 176, n0 = 32 * nb; transpose_item((const float*)a.in[I_FU], DM, FF, WguT, DM, 256 * (n0 / 128) + 128 + (n0 % 128), 64 * kb, n0, scr, lane); continue; } r_ -= I_G;
            if (r_ < I_D) { const int kb = r_ / 64, nb = r_ % 64; transpose_item((const float*)a.in[I_FD], FF, DM, WdownT, FF, 32 * nb, 64 * kb, 32 * nb, scr, lane); continue; } r_ -= I_D;
            if (r_ < I_LD) { const int kb = r_ / 32, nb = r_ % 32; transpose_item((const float*)a.in[I_WDEC], 64, 1024, WdT, 256, 32 * nb, 64 * kb, 32 * nb, scr, lane); continue; } r_ -= I_LD;
            if (r_ < I_LD) { const int kb = r_ / 32, nb = r_ % 32; transpose_item((const float*)a.in[I_WICLR], 64, 1024, WaT, 256, 32 * nb, 64 * kb, 32 * nb, scr, lane); continue; } r_ -= I_LD;
            { const int kb = r_ / 32, nb = r_ % 32; transpose_item((const float*)a.in[I_WGATE], 160, 1024, WgT, 256, 32 * nb, 64 * kb, 32 * nb, scr, lane); }
        }
        { u32x4* z = (u32x4*)(WinT + (size_t)NPROJ * DM); for (int idx = gt; idx < (LDP - NPROJ) * DM * 2 / 16; idx += NGT) z[idx] = (u32x4){0u, 0u, 0u, 0u}; }
        for (int idx = gt; idx < 3072; idx += NGT) lbias[idx] = (idx < 1024) ? ((const float*)a.in[I_W0])[idx] : (idx < 2048) ? ((const float*)a.in[I_A0])[idx - 1024] : 0.f;
        {
            const float* wada = (const float*)a.in[I_WADA]; const float* cvec = (const float*)a.in[I_C];
            for (int it = bx; it < 768; it += G) {
                const int ks = it / 6, cb = it % 6, n = cb * 2048 + tid * 4;
                f32x4 s0 = {0.f, 0.f, 0.f, 0.f}, s1 = {0.f, 0.f, 0.f, 0.f};
#pragma unroll
                for (int kk = 0; kk < 16; ++kk) { const int k = ks * 16 + kk; const f32x4 wv = *(const f32x4*)(wada + (size_t)k * ADA_N + n);
                    const float c0 = cvec[k], c1 = cvec[DM + k]; const float e0 = c0 * sigmoidf_(c0), e1 = c1 * sigmoidf_(c1); s0 += wv * e0; s1 += wv * e1; }
                *(f32x4*)(adap + (size_t)(ks * 2 + 0) * ADA_N + n) = s0; *(f32x4*)(adap + (size_t)(ks * 2 + 1) * ADA_N + n) = s1;
            }
        }
        {
            const int* pos = (const int*)a.in[I_POS];
            for (int idx = gt; idx < T * 8; idx += NGT) {
                const int row = idx >> 3, i = idx & 7;
                const float inv = (float)exp(-(double)i * 0.125 * 13.122363377404328);
                const float ang = (float)pos[row] * inv;
                const double ad = (double)ang; const double nq = rint(ad * 0.6366197723675814); const double rr = ad - nq * 1.5707963267948966; const double r2 = rr * rr;
                const double sn = rr * (1.0 + r2 * (-1.0 / 6 + r2 * (1.0 / 120 + r2 * (-1.0 / 5040 + r2 * (1.0 / 362880 + r2 * (-1.0 / 39916800 + r2 * (1.0 / 6227020800.0)))))));
                const double cn = 1.0 + r2 * (-0.5 + r2 * (1.0 / 24 + r2 * (-1.0 / 720 + r2 * (1.0 / 40320 + r2 * (-1.0 / 3628800 + r2 * (1.0 / 479001600 + r2 * (-1.0 / 87178291200.0)))))));
                const int qd = ((int)nq) & 3;
                const double cv = (qd == 0) ? cn : (qd == 1) ? -sn : (qd == 2) ? -cn : sn;
                const double sv = (qd == 0) ? sn : (qd == 1) ? cn : (qd == 2) ? -sn : -cn;
                rope[(size_t)row * 16 + i] = (float)cv; rope[(size_t)row * 16 + 8 + i] = (float)sv;
            }
        }
    }
    SYNC(0);
    if (IN(1)) {
        PH_IDS;
        const float* bada = (const float*)a.in[I_BADA];
        for (int id4 = gt; id4 < 4 * 2 * ADA_N; id4 += NGT) {
            const int idx = id4 >> 2, part = id4 & 3, b = idx / ADA_N, n = idx % ADA_N;
            float s0 = 0.f, s1 = 0.f, s2 = 0.f, s3 = 0.f;
#pragma unroll
            for (int k = 0; k < 32; k += 4) {
                s0 += adap[(size_t)((part * 32 + k + 0) * 2 + b) * ADA_N + n]; s1 += adap[(size_t)((part * 32 + k + 1) * 2 + b) * ADA_N + n];
                s2 += adap[(size_t)((part * 32 + k + 2) * 2 + b) * ADA_N + n]; s3 += adap[(size_t)((part * 32 + k + 3) * 2 + b) * ADA_N + n]; }
            float sm = (s0 + s1) + (s2 + s3);
            sm += __shfl_xor(sm, 1); sm += __shfl_xor(sm, 2);
            if (part == 0) ada[idx] = sm + bada[n];
        }
    }
    SYNC(1);
    if (IN(2)) { PH_IDS; norm_rows_mod(x_in, hbuf, (const float*)a.in[I_N1G], ada + 1 * DM, ada + 0 * DM, gw, NGW, lane); }
    SYNC(2);
    REPS(3) if (IN(3)) {
        PH_WS;
        pg8::Gemm g{hbuf, WinT, T, LDP, DM, DM, DM, 0, 0}; pg8::StaticOrder S; S.init(T, LDP, G, bx);
        pg8::EpiProj E{proj, LDP, rope};
        pg8::gemm_phase<pg8::EpiProj, pg8::StaticOrder>(lds, g, S, E, wave_s);
    }
    SYNC(3);
    if (IN(4)) {
        PH_IDS;
        const float* mu = (const float*)a.in[I_MU]; const float* k_k = (const float*)a.in[I_KK];
        for (int row = gw; row < T; row += NGW) {
            const bool first = (row % SEQ) == 0;
            const bf16_t* pr = proj + (size_t)row * LDP; const bf16_t* pp = pr - LDP;
            { const int c0 = 16 * lane; float ss = 0.f;
              const u32x4 k0 = *(const u32x4*)(pr + PC_RK + c0), k1 = *(const u32x4*)(pr + PC_RK + c0 + 8);
              u32x4 p0 = {0u, 0u, 0u, 0u}, p1 = {0u, 0u, 0u, 0u};
              if (!first) { p0 = *(const u32x4*)(pp + PC_RK + c0); p1 = *(const u32x4*)(pp + PC_RK + c0 + 8); }
#pragma unroll
              for (int e = 0; e < 16; ++e) {
                  const unsigned cw = (e < 8) ? k0[e >> 1] : k1[(e - 8) >> 1], pw = (e < 8) ? p0[e >> 1] : p1[(e - 8) >> 1];
                  const float kc = (e & 1) ? __uint_as_float(cw & 0xffff0000u) : __uint_as_float(cw << 16);
                  const float kp = (e & 1) ? __uint_as_float(pw & 0xffff0000u) : __uint_as_float(pw << 16);
                  const float k = kc + (kp - kc) * mu[1024 + c0 + e];
                  const float t = k * k_k[c0 + e]; ss += t * t; }
              ss += __shfl_xor(ss, 1); ss += __shfl_xor(ss, 2);
              if ((lane & 3) == 0) kkn[(size_t)row * 16 + (lane >> 2)] = 1.0f / fmaxf(sqrtf(ss), 1e-12f); }
#pragma unroll
            for (int i = 0; i < 12; ++i) {
                const int d = lane + 64 * i; int src = -1, mode = 0;
                if (d < 64) { src = PC_WL + d; mode = 0; } else if (d >= 256 && d < 320) { src = PC_AL + (d - 256); mode = 1; } else if (d >= 512 && d < 672) { src = PC_GL + (d - 512); mode = 2; }
                float val = 0.f;
                if (src >= 0) { const float yc = bf2f(pr[src]); const float yp = first ? 0.f : bf2f(pp[src]); const float y = yc + (yp - yc) * mu[src - 3072];
                    val = (mode == 0) ? tanhf(y) : (mode == 1) ? y : sigmoidf_(y); }
                lact[(size_t)row * 768 + d] = (bf16_t)f2bf(val);
            }
        }
    }
    SYNC(4);
    if (IN(5)) {
        PH_WS; pg8::StaticOrder S; S.init(T, 3072, G, bx);
        pg8::Gemm g{lact, WdT, T, 3072, 256, 768, 256, 256, 128};
        pg8::EpiLora E{lz, lbias};
        pg8::gemm_phase<pg8::EpiLora, pg8::StaticOrder>(lds, g, S, E, wave_s);
    }
    SYNC(5);
#define MK_SCANPTRS ScanPtrs sp{proj, lz, kkn, (const float*)a.in[I_MU], (const float*)a.in[I_KK], (const float*)a.in[I_KA], (const float*)a.in[I_RK], (const float*)a.in[I_GNG], (const float*)a.in[I_GNB], cs, sinit, mix}
    REPS(6) if (IN(6)) {
        PH_IDS; MK_SCANPTRS;
        LAS float* W = (LAS float*)(lds + wave * 16384);
        for (int it = gw; it < 2 * NCHAIN * NCH; it += NGW) { const int which = it / (NCHAIN * NCH), cc = it % (NCHAIN * NCH);
            if (which == 0) scan_item<0, 8>(W, sp, cc / NCH, cc % NCH, lane); else scan_item<1, 8>(W, sp, cc / NCH, cc % NCH, lane); }
    }
    SYNC(6);
    REPS(7) if (IN(7)) {
        PH_IDS;
        if (bx < NCHAIN) { scan_combine((LAS float*)lds, cs, sinit, bx, tid); __syncthreads(); }
        int ubeg, ustride, ucnt;
        if (G == 256) { const int j = bx - NCHAIN;
            if (bx < NCHAIN) { ubeg = 192 * 51 + 32 * 50 + bx * 28; ucnt = 28; } else if (j < 192) { ubeg = j * 51; ucnt = 51; } else { ubeg = 192 * 51 + (j - 192) * 50; ucnt = 50; } ustride = 1; }
        else { ubeg = bx; ustride = G; ucnt = (ATT_UNITS - bx + G - 1) / G; }
        attn_phase(lds, ubeg, ustride, ucnt, proj, hbuf, op2, lse, tid);
    }
    SYNC(7);
    REPS(8) if (IN(8)) {
        PH_IDS; MK_SCANPTRS;
        LAS float* W = (LAS float*)(lds + wave * 16384);
        for (int it = gw; it < NCHAIN * NCH; it += NGW) scan_item<2, 8>(W, sp, it / NCH, it % NCH, lane);
        for (int idx = gt; idx < T * 128; idx += NGT) {
            const int row = idx >> 7, c8 = idx & 127, h = c8 >> 3;
            const int bb_ = row / SEQ, s_ = row % SEQ, ub_ = (bb_ * 16 + h) * 384;
            const float l0 = lse[(size_t)(ub_ + 0 * 128 + (s_ >> 7)) * 128 + (s_ & 127)];
            const float l1 = lse[(size_t)(ub_ + 1 * 128 + (s_ & 3) * 32 + (s_ >> 9)) * 128 + ((s_ >> 2) & 127)];
            const float l2 = lse[(size_t)(ub_ + 2 * 128 + (s_ & 15) * 8 + (s_ >> 11)) * 128 + ((s_ >> 4) & 127)];
            const float mxl = fmaxf(l0, fmaxf(l1, l2));
            float w0 = __expf(l0 - mxl), w1 = __expf(l1 - mxl), w2 = __expf(l2 - mxl); const float wi = 1.0f / (w0 + w1 + w2); w0 *= wi; w1 *= wi; w2 *= wi;
            const u32x4 o0 = *(const u32x4*)(hbuf + (size_t)row * 1024 + c8 * 8), o1 = *(const u32x4*)(hbuf + (size_t)T * 1024 + (size_t)row * 1024 + c8 * 8), o2 = *(const u32x4*)(op2 + (size_t)row * 1024 + c8 * 8);
            u32x4 ov;
#pragma unroll
            for (int e = 0; e < 4; ++e) {
                const float lo = w0 * __uint_as_float(o0[e] << 16) + w1 * __uint_as_float(o1[e] << 16) + w2 * __uint_as_float(o2[e] << 16);
                const float hi = w0 * __uint_as_float(o0[e] & 0xffff0000u) + w1 * __uint_as_float(o1[e] & 0xffff0000u) + w2 * __uint_as_float(o2[e] & 0xffff0000u);
                ov[e] = pk2(lo, hi); }
            *(u32x4*)(mix + (size_t)row * DM + c8 * 8) = ov;
        }
    }
    SYNC(8);
    if (IN(9)) {
        PH_WS;
        pg8::Gemm g{mix, WoutT, T, DM, DM, DM, DM, 0, 0};
        if (G == 256) {
            pg8::PanelOrder S{bx};
            pg8::EpiResidNorm<true> E{x_in, outp, ada + 2 * DM, (const float*)a.in[I_N2G], (unsigned*)(ws + WS_ADAP + 1 * MiB), ctl + 16384 + 8192, (LAS float*)(lds + 131072), hbuf, ada};
            pg8::gemm_phase<pg8::EpiResidNorm<true>, pg8::PanelOrder>(lds, g, S, E, wave_s);
        } else {
            pg8::StaticOrder S; S.init(T, DM, G, bx);
            pg8::EpiResid E{x_in, outp, ada + 2 * DM};
            pg8::gemm_phase<pg8::EpiResid, pg8::StaticOrder>(lds, g, S, E, wave_s);
        }
    }
    SYNC(9);
    if (IN(10) && G != 256) { PH_IDS; norm_rows_mod(outp, hbuf, (const float*)a.in[I_N2G], ada + 4 * DM, ada + 3 * DM, gw, NGW, lane); }
    if (G != 256) SYNC(10);
    REPS(11) if (IN(11)) {
        PH_WS;
        pg8::Gemm g{hbuf, WguT, T, 2 * FF, DM, DM, DM, 0, 0}; pg8::StaticOrder S; S.init(T, 2 * FF, G, bx);
        pg8::EpiSwiglu E{hid};
        pg8::gemm_phase<pg8::EpiSwiglu, pg8::StaticOrder>(lds, g, S, E, wave_s);
    }
    SYNC(11);
    if (IN(12)) {
        PH_WS;
        pg8::Gemm g{hid, WdownT, T, DM, FF, FF, FF, 0, 0};
        if (G == 256) {
            pg8::PanelOrder S{bx};
            pg8::EpiResidNorm<false> E{outp, outp, ada + 5 * DM, (const float*)a.in[I_NFG], (unsigned*)(ws + WS_ADAP), ctl + 16384, (LAS float*)(lds + 131072), nullptr, ada};
            pg8::gemm_phase<pg8::EpiResidNorm<false>, pg8::PanelOrder>(lds, g, S, E, wave_s);
        } else {
            pg8::StaticOrder S; S.init(T, DM, G, bx);
            pg8::EpiResid E{outp, outp, ada + 5 * DM};
            pg8::gemm_phase<pg8::EpiResid, pg8::StaticOrder>(lds, g, S, E, wave_s);
        }
    }
    if (G != 256) SYNC(12);
    if (IN(13) && G != 256) {
        PH_IDS;
        const float* gf = (const float*)a.in[I_NFG];
        for (int row = gw; row < T; row += NGW) {
            f32x4* xr = (f32x4*)(outp + (size_t)row * DM) + lane;
            f32x4 v[8]; float ss = 0.f;
#pragma unroll
            for (int j = 0; j < 8; ++j) { v[j] = xr[64 * j]; ss += (v[j].x * v[j].x + v[j].y * v[j].y) + (v[j].z * v[j].z + v[j].w * v[j].w); }
            const float rstd = 1.0f / sqrtf(wave_sum(ss) * (1.0f / DM) + 1e-6f);
#pragma unroll
            for (int j = 0; j < 8; ++j) { const f32x4 g4 = *(const f32x4*)(gf + 4 * lane + 256 * j); xr[64 * j] = (v[j] * rstd) * g4; }
        }
    }
#undef IN
#undef SYNC
}

#ifndef MK_PER_PHASE
#define MK_PER_PHASE 0
#endif
constexpr int N_PHASES = 14;
extern "C" void kernel_launch(void* const* d_in, const int* in_sizes, int n_in, void* d_out, int out_size, void* d_ws, size_t ws_size, hipStream_t stream) {
    static int grid = 0;
    if (grid == 0) {
        if (n_in != 24 || in_sizes[0] != T * DM || out_size != T * DM || ws_size < WS_END) { fprintf(stderr, "kernel_launch: unexpected shapes: n_in %d in0 %d out %d ws %zu (need %zu)\n", n_in, n_in > 0 ? in_sizes[0] : -1, out_size, ws_size, (size_t)WS_END); grid = -1; return; }
        int dev = 0, cus = 0, per_cu = 0;
        if (hipGetDevice(&dev) != hipSuccess || hipDeviceGetAttribute(&cus, hipDeviceAttributeMultiprocessorCount, dev) != hipSuccess) { fprintf(stderr, "kernel_launch: device query failed\n"); grid = -1; return; }
        if (hipFuncSetAttribute((const void*)mk_fwd, hipFuncAttributeMaxDynamicSharedMemorySize, LDS_BYTES) != hipSuccess) { fprintf(stderr, "kernel_launch: hipFuncSetAttribute failed\n"); grid = -1; return; }
        if (hipOccupancyMaxActiveBlocksPerMultiprocessor(&per_cu, (const void*)mk_fwd, 512, LDS_BYTES) != hipSuccess || per_cu < 1) { fprintf(stderr, "kernel_launch: occupancy query says %d\n", per_cu); per_cu = 1; }
        (void)hipGetLastError();
        grid = cus * per_cu;
    }
    if (grid < 0) return;
    if (hipMemsetAsync((char*)d_ws + WS_CTL, 0, 1 * MiB, stream) != hipSuccess) { fprintf(stderr, "kernel_launch: memset failed\n"); return; }
    Args a{};
    for (int i = 0; i < 24; ++i) a.in[i] = d_in[i];
    a.out = (float*)d_out; a.ws = (unsigned char*)d_ws;
#if MK_PER_PHASE
    for (int ph = 0; ph < N_PHASES; ++ph) {
        a.ph_lo = ph; a.ph_hi = ph + 1;
        hipLaunchKernelGGL(mk_fwd, dim3(grid), dim3(512), LDS_BYTES, stream, a);
    }
#else
    a.ph_lo = 0; a.ph_hi = N_PHASES;
    void* args[] = {&a};
    hipError_t e = hipLaunchCooperativeKernel((const void*)mk_fwd, dim3(grid), dim3(512), args, LDS_BYTES, stream);
    if (e != hipSuccess) fprintf(stderr, "kernel_launch: cooperative launch failed: %s (grid %d)\n", hipGetErrorString(e), grid);
#endif
}
```
